# Optimizing an MI355X kernel written in HIP

```python
import math
import jax
import jax.numpy as jnp
from jax import lax
import numpy as np

D_MODEL = 1024
BATCH = 2
SEQ = 16384
DEPTH = 1

MEM_LEN = 256
EPS = 1e-6
N_BRANCH = 3

SSM_WIDTH = D_MODEL // 2
SSM_GROUP = 16
SSM_GROUPS = SSM_WIDTH // SSM_GROUP
SSM_STATE = 64
DT_MIN = 1e-3
DT_MAX = 1e-1

MOBA_HEAD_DIM = 64
MOBA_HEADS = (D_MODEL // 2) // MOBA_HEAD_DIM
MOBA_WIDTH = MOBA_HEADS * MOBA_HEAD_DIM
MOBA_BLOCK = 256
MOBA_TOPK = 3
MOBA_QCHUNK = 64
ROPE_THETA = 10000.0

X_HEADS = 4
X_HEAD_DIM = (D_MODEL // 2) // X_HEADS
X_WIDTH = X_HEADS * X_HEAD_DIM

IN_SPLITS = (SSM_WIDTH, SSM_WIDTH + MOBA_WIDTH, SSM_WIDTH + 2 * MOBA_WIDTH, SSM_WIDTH + 3 * MOBA_WIDTH, SSM_WIDTH + 3 * MOBA_WIDTH + X_WIDTH)
IN_COLS = IN_SPLITS[-1] + N_BRANCH * D_MODEL

N_EXPERTS = 32
TOPK_EXPERTS = 4
D_EXPERT = D_MODEL
SWIGLU_LIMIT = 7.0
SWIGLU_ALPHA = 1.702
EXPERT_ROWS = 512

kernel_name = "hybrid_s5_moba_xattn_moe_layer"


def rms_norm(x, g):
    xf = x.astype(jnp.float32)
    y = xf * lax.rsqrt(jnp.mean(xf * xf, axis=-1, keepdims=True) + EPS)
    return (y * g.astype(jnp.float32)).astype(x.dtype)


def rope(x):
    L, dh = x.shape[1], x.shape[3]
    half = dh // 2
    inv = ROPE_THETA ** (-jnp.arange(half, dtype=jnp.float32) / half)
    ang = jnp.arange(L, dtype=jnp.float32)[:, None] * inv[None, :]
    cos = jnp.cos(ang)[None, :, None, :]
    sin = jnp.sin(ang)[None, :, None, :]
    x1 = x[..., :half].astype(jnp.float32)
    x2 = x[..., half:].astype(jnp.float32)
    return jnp.concatenate([x1 * cos - x2 * sin, x2 * cos + x1 * sin], axis=-1).astype(x.dtype)


def s5_glu(u, lam_re, lam_im, log_dt, b_re, b_im, c_re, c_im, d_skip, w_glu):
    Bsz, L, _ = u.shape
    ug = u.reshape(Bsz, L, SSM_GROUPS, SSM_GROUP)
    dt = jnp.exp(log_dt)[:, None]
    mag = jnp.exp(lam_re * dt)
    ar = mag * jnp.cos(lam_im * dt)
    ai = mag * jnp.sin(lam_im * dt)
    nr = ar - 1.0
    den = lam_re * lam_re + lam_im * lam_im
    cr = (nr * lam_re + ai * lam_im) / den
    ci = (ai * lam_re - nr * lam_im) / den
    bbr = cr[..., None] * b_re - ci[..., None] * b_im
    bbi = cr[..., None] * b_im + ci[..., None] * b_re
    xr = jnp.einsum('blgh,gph->blgp', ug, bbr)
    xi = jnp.einsum('blgh,gph->blgp', ug, bbi)
    a_r = jnp.broadcast_to(ar, (1, L) + ar.shape)
    a_i = jnp.broadcast_to(ai, (1, L) + ai.shape)

    def combine(e1, e2):
        a1r, a1i, s1r, s1i = e1
        a2r, a2i, s2r, s2i = e2
        return (a2r * a1r - a2i * a1i,
                a2r * a1i + a2i * a1r,
                a2r * s1r - a2i * s1i + s2r,
                a2r * s1i + a2i * s1r + s2i)

    _, _, sr, si = lax.associative_scan(combine, (a_r, a_i, xr, xi), axis=1)
    y = jnp.einsum('blgp,ghp->blgh', sr, c_re) - jnp.einsum('blgp,ghp->blgh', si, c_im)
    y = y.reshape(Bsz, L, SSM_WIDTH) + d_skip * u
    z = jax.nn.gelu(y) @ w_glu
    return z[..., :D_MODEL] * jax.nn.sigmoid(z[..., D_MODEL:])


def moba_attention(q, k, v):
    Bsz, H, L, dh = q.shape
    nb = -(-L // MOBA_BLOCK)
    ksel = min(MOBA_TOPK, nb)
    pad = nb * MOBA_BLOCK - L
    kb = jnp.pad(k, ((0, 0), (0, 0), (0, pad), (0, 0))).reshape(Bsz, H, nb, MOBA_BLOCK, dh)
    vb = jnp.pad(v, ((0, 0), (0, 0), (0, pad), (0, 0))).reshape(Bsz, H, nb, MOBA_BLOCK, dh)
    kmean = jnp.mean(kb.astype(jnp.float32), axis=3)
    kb_flat = kb.reshape(Bsz * H * nb, MOBA_BLOCK, dh)
    vb_flat = vb.reshape(Bsz * H * nb, MOBA_BLOCK, dh)
    bh_base = ((jnp.arange(Bsz)[:, None] * H + jnp.arange(H)[None, :]) * nb)[:, :, None, None]
    scale = dh ** -0.5
    blk_ids = jnp.arange(nb)
    kpos_in = jnp.arange(MOBA_BLOCK)
    qoff = jnp.arange(MOBA_QCHUNK)

    def chunk(c):
        q0 = c * MOBA_QCHUNK
        qblk = q0 // MOBA_BLOCK
        qc = lax.dynamic_slice_in_dim(q, q0, MOBA_QCHUNK, axis=2)
        gate = jnp.einsum('bhqd,bhnd->bhqn', qc.astype(jnp.float32), kmean)
        gate = jnp.where(blk_ids < qblk, gate, -jnp.inf)
        _, sel = lax.top_k(gate, ksel)
        sel_ok = sel < qblk
        gidx = bh_base + sel
        kg = kb_flat[gidx]
        vg = vb_flat[gidx]
        s_sel = jnp.einsum('bhqd,bhqskd->bhqsk', qc, kg).astype(jnp.float32) * scale
        s_sel = jnp.where(sel_ok[..., None], s_sel, -jnp.inf).reshape(Bsz, H, MOBA_QCHUNK, ksel * MOBA_BLOCK)
        k_own = lax.dynamic_index_in_dim(kb, qblk, axis=2, keepdims=False)
        v_own = lax.dynamic_index_in_dim(vb, qblk, axis=2, keepdims=False)
        s_own = jnp.einsum('bhqd,bhkd->bhqk', qc, k_own).astype(jnp.float32) * scale
        causal = (qblk * MOBA_BLOCK + kpos_in)[None, :] <= (q0 + qoff)[:, None]
        s_own = jnp.where(causal, s_own, -jnp.inf)
        p = jax.nn.softmax(jnp.concatenate([s_sel, s_own], axis=-1), axis=-1).astype(v.dtype)
        p_sel = p[..., :ksel * MOBA_BLOCK].reshape(Bsz, H, MOBA_QCHUNK, ksel, MOBA_BLOCK)
        p_own = p[..., ksel * MOBA_BLOCK:]
        return (jnp.einsum('bhqsk,bhqskd->bhqd', p_sel, vg)
                + jnp.einsum('bhqk,bhkd->bhqd', p_own, v_own))

    out = lax.map(chunk, jnp.arange(L // MOBA_QCHUNK))
    return out.transpose(1, 0, 3, 2, 4).reshape(Bsz, L, H * dh)


def memory_cross_attention(xq, mem, g_mem, w_kv_mem, g_cq, g_ck):
    Bsz, L, _ = xq.shape
    M = mem.shape[1]
    q = rms_norm(xq.reshape(Bsz, L, X_HEADS, X_HEAD_DIM), g_cq)
    kv = rms_norm(mem, g_mem) @ w_kv_mem
    k = rms_norm(kv[..., :X_WIDTH].reshape(Bsz, M, X_HEADS, X_HEAD_DIM), g_ck)
    v = kv[..., X_WIDTH:].reshape(Bsz, M, X_HEADS, X_HEAD_DIM)
    s = jnp.einsum('blhd,bmhd->bhlm', q, k).astype(jnp.float32) * (X_HEAD_DIM ** -0.5)
    p = jax.nn.softmax(s, axis=-1).astype(v.dtype)
    return jnp.einsum('bhlm,bmhd->blhd', p, v).reshape(Bsz, L, X_WIDTH)


def moe_ffn(h, w_router, b_router, w_gu, b_gu, w_down, b_down):
    Bsz, L, D = h.shape
    T = Bsz * L
    TK = T * TOPK_EXPERTS
    ht = h.reshape(T, D)
    logits = (ht @ w_router + b_router).astype(jnp.float32)
    top_v, top_e = lax.top_k(logits, TOPK_EXPERTS)
    weights = jax.nn.softmax(top_v, axis=-1)
    e_flat = top_e.reshape(TK)
    tok_flat = jnp.arange(TK, dtype=jnp.int32) // TOPK_EXPERTS
    w_flat = weights.reshape(TK)
    order = jnp.argsort(e_flat)
    e_s, tok_s, w_s = e_flat[order], tok_flat[order], w_flat[order]
    counts = jnp.bincount(e_flat, length=N_EXPERTS)
    starts = jnp.cumsum(counts) - counts
    pcounts = ((counts + EXPERT_ROWS - 1) // EXPERT_ROWS) * EXPERT_ROWS
    pends = jnp.cumsum(pcounts)
    pstarts = pends - pcounts
    dest = pstarts[e_s] + (jnp.arange(TK) - starts[e_s])
    nblk = -(-TK // EXPERT_ROWS) + N_EXPERTS
    P = nblk * EXPERT_ROWS
    slot_tok = jnp.full((P,), T, jnp.int32).at[dest].set(tok_s)
    slot_w = jnp.zeros((P,), h.dtype).at[dest].set(w_s.astype(h.dtype))
    blk_e = jnp.minimum(jnp.searchsorted(pends, jnp.arange(nblk) * EXPERT_ROWS, side='right'), N_EXPERTS - 1)
    h_pad = jnp.concatenate([ht, jnp.zeros((1, D), ht.dtype)], axis=0)
    xs = h_pad[slot_tok].reshape(nblk, EXPERT_ROWS, D)

    def expert_block(args):
        xb, e = args
        gu = xb @ w_gu[e] + b_gu[e]
        gate = jnp.minimum(gu[:, :D_EXPERT], SWIGLU_LIMIT)
        up = jnp.clip(gu[:, D_EXPERT:], -SWIGLU_LIMIT, SWIGLU_LIMIT)
        act = gate * jax.nn.sigmoid(SWIGLU_ALPHA * gate) * (up + 1.0)
        return act @ w_down[e] + b_down[e]

    ys = lax.map(expert_block, (xs, blk_e)).reshape(P, D)
    out = jnp.zeros((T + 1, D), h.dtype).at[slot_tok].add(ys * slot_w[:, None])
    return out[:T].reshape(Bsz, L, D)


def setup_inputs(seed: int = 0) -> dict:
    key = jax.random.key(seed)
    ks = jax.random.split(key, 28)
    f32 = jnp.float32

    def nrm(k, shape, scale):
        return jax.random.normal(k, shape, f32) * scale

    def gain(k, shape):
        return 1.0 + 0.01 * jax.random.normal(k, shape, f32)

    NL, D = DEPTH, D_MODEL
    G, P, HG = SSM_GROUPS, SSM_STATE, SSM_GROUP
    n = jnp.arange(P, dtype=f32)
    return {
        "x": nrm(ks[0], (BATCH, SEQ, D), 1.0),
        "mem": nrm(ks[1], (BATCH, MEM_LEN, D), 1.0),
        "g_mix": gain(ks[2], (NL, D)),
        "w_in": nrm(ks[3], (NL, D, IN_COLS), D ** -0.5),
        "lam_re": -0.5 + 0.01 * jax.random.normal(ks[4], (NL, G, P), f32),
        "lam_im": jnp.broadcast_to(math.pi * n, (NL, G, P)),
        "log_dt": jax.random.uniform(ks[5], (NL, G), f32, math.log(DT_MIN), math.log(DT_MAX)),
        "b_re": nrm(ks[6], (NL, G, P, HG), HG ** -0.5),
        "b_im": nrm(ks[7], (NL, G, P, HG), HG ** -0.5),
        "c_re": nrm(ks[8], (NL, G, HG, P), P ** -0.5),
        "c_im": nrm(ks[9], (NL, G, HG, P), P ** -0.5),
        "d_skip": nrm(ks[10], (NL, SSM_WIDTH), 1.0),
        "w_glu": nrm(ks[11], (NL, SSM_WIDTH, 2 * D), SSM_WIDTH ** -0.5),
        "g_q": gain(ks[12], (NL, MOBA_HEAD_DIM)),
        "g_k": gain(ks[13], (NL, MOBA_HEAD_DIM)),
        "w_moba_out": nrm(ks[14], (NL, MOBA_WIDTH, D), MOBA_WIDTH ** -0.5),
        "g_mem": gain(ks[15], (NL, D)),
        "w_kv_mem": nrm(ks[16], (NL, D, 2 * X_WIDTH), D ** -0.5),
        "g_cq": gain(ks[17], (NL, X_HEAD_DIM)),
        "g_ck": gain(ks[18], (NL, X_HEAD_DIM)),
        "w_cross_out": nrm(ks[19], (NL, X_WIDTH, D), X_WIDTH ** -0.5),
        "w_out": nrm(ks[20], (NL, D, D), D ** -0.5),
        "g_ffn": gain(ks[21], (NL, D)),
        "w_router": nrm(ks[22], (NL, D, N_EXPERTS), D ** -0.5),
        "b_router": nrm(ks[23], (NL, N_EXPERTS), 0.01),
        "w_gu": nrm(ks[24], (NL, N_EXPERTS, D, 2 * D_EXPERT), D ** -0.5),
        "b_gu": nrm(ks[25], (NL, N_EXPERTS, 2 * D_EXPERT), 0.01),
        "w_down": nrm(ks[26], (NL, N_EXPERTS, D_EXPERT, D), D_EXPERT ** -0.5),
        "b_down": nrm(ks[27], (NL, N_EXPERTS, D), 0.01),
    }


def reference(x, mem, g_mix, w_in, lam_re, lam_im, log_dt, b_re, b_im, c_re, c_im, d_skip, w_glu,
              g_q, g_k, w_moba_out, g_mem, w_kv_mem, g_cq, g_ck, w_cross_out, w_out, g_ffn,
              w_router, b_router, w_gu, b_gu, w_down, b_down):
    Bsz, L, D = x.shape
    for l in range(DEPTH):
        h = rms_norm(x, g_mix[l])
        u, q, k, v, xq, gate_logits = jnp.split(h @ w_in[l], IN_SPLITS, axis=-1)
        y_ssm = s5_glu(u, lam_re[l], lam_im[l], log_dt[l], b_re[l], b_im[l], c_re[l], c_im[l], d_skip[l], w_glu[l])
        q = rope(rms_norm(q.reshape(Bsz, L, MOBA_HEADS, MOBA_HEAD_DIM), g_q[l])).transpose(0, 2, 1, 3)
        k = rope(rms_norm(k.reshape(Bsz, L, MOBA_HEADS, MOBA_HEAD_DIM), g_k[l])).transpose(0, 2, 1, 3)
        v = v.reshape(Bsz, L, MOBA_HEADS, MOBA_HEAD_DIM).transpose(0, 2, 1, 3)
        y_moba = moba_attention(q, k, v) @ w_moba_out[l]
        y_mem = memory_cross_attention(xq, mem, g_mem[l], w_kv_mem[l], g_cq[l], g_ck[l]) @ w_cross_out[l]
        g = jax.nn.sigmoid(gate_logits.reshape(Bsz, L, N_BRANCH, D))
        merged = g[:, :, 0] * y_ssm + g[:, :, 1] * y_moba + g[:, :, 2] * y_mem
        x = x + merged @ w_out[l]
        x = x + moe_ffn(rms_norm(x, g_ffn[l]), w_router[l], b_router[l], w_gu[l], b_gu[l], w_down[l], b_down[l])
    return x
```

```cpp
#include <hip/hip_runtime.h>
#include <hip/hip_cooperative_groups.h>
#include <cstdio>
#include <math.h>
#include <stdint.h>
namespace cg = cooperative_groups;

#define D_MODEL 1024
#define BATCH 2
#define SEQ 16384
#define TTOK (BATCH * SEQ)
#define IN_COLS 5632
#define NEXP 32

__device__ __forceinline__ void sincos_acc(float ang, float& s, float& c) {
  double a = (double)ang;
  double kf = rint(a * 0.6366197723675814);
  double r = fma(-kf, 1.5707963267948966, a);
  r = fma(-kf, 6.123233995736766e-17, r);
  int q = ((int)kf) & 3;
  float x = (float)r;
  float x2 = x * x;
  float sp = x + x * x2 * (-1.6666654611e-1f + x2 * (8.3321608736e-3f + x2 * (-1.9515295891e-4f)));
  float cp = 1.0f - 0.5f * x2 + x2 * x2 * (4.166664568298827e-2f + x2 * (-1.388731625493765e-3f + x2 * 2.443315711809948e-5f));
  float ss = (q & 1) ? cp : sp;
  float cc = (q & 1) ? sp : cp;
  if (q == 1 || q == 2) cc = -cc;
  if (q >= 2) ss = -ss;
  s = ss; c = cc;
}


#define NTHR 512
typedef __attribute__((ext_vector_type(8))) short bf16x8;
typedef __attribute__((ext_vector_type(4))) float f32x4;
typedef unsigned short u16;
typedef __attribute__((ext_vector_type(4))) unsigned int u32x4;
typedef __attribute__((ext_vector_type(2))) unsigned int u32x2;

__device__ __forceinline__ u16 f2bf(float f) {
  unsigned int u = __float_as_uint(f);
  u += 0x7fffu + ((u >> 16) & 1u);
  return (u16)(u >> 16);
}
__device__ __forceinline__ float bf2f(u16 h) { return __uint_as_float(((unsigned int)h) << 16); }
__device__ __forceinline__ unsigned int pack2(float a, float b) { return (unsigned int)f2bf(a) | ((unsigned int)f2bf(b) << 16); }

#define TK_ROWS (TTOK * 4)
constexpr size_t al256(size_t x) { return (x + 255) & ~(size_t)255; }
constexpr size_t WS_WT_IN = 0;
constexpr size_t WS_WT_GLU = WS_WT_IN + (size_t)5632 * 1024 * 2;
constexpr size_t WS_WT_MO = WS_WT_GLU + (size_t)2048 * 512 * 2;
constexpr size_t WS_WT_CO = WS_WT_MO + (size_t)1024 * 512 * 2;
constexpr size_t WS_WT_OUT = WS_WT_CO + (size_t)1024 * 512 * 2;
constexpr size_t WS_WT_KV = WS_WT_OUT + (size_t)1024 * 1024 * 2;
constexpr size_t WS_WT_GU = WS_WT_KV + (size_t)1024 * 1024 * 2;
constexpr size_t WS_WT_DOWN = WS_WT_GU + (size_t)32 * 2048 * 1024 * 2;
constexpr size_t WS_GW = WS_WT_DOWN + (size_t)32 * 1024 * 1024 * 2;
constexpr size_t WS_CNT = WS_GW + (size_t)1024 * 32 * 4;
constexpr size_t WS_KT = al256(WS_CNT + 8192);
constexpr size_t WS_FT = WS_KT + (size_t)32 * 127 * 256 * 2;
constexpr size_t WS_ET = WS_FT + (size_t)32 * 128 * 1024 * 2;
constexpr size_t WS_A64 = WS_ET + (size_t)32 * 1024 * 128 * 2;
constexpr size_t WS_ROPE = al256(WS_A64 + (size_t)32 * 64 * 2 * 4);
constexpr size_t WS_M0 = al256(WS_ROPE + (size_t)SEQ * 64 * 4);
constexpr size_t WS_PROJ = WS_M0;
constexpr size_t WS_H = WS_PROJ + (size_t)TTOK * 5632 * 2;
constexpr size_t WS_VT = WS_H + (size_t)TTOK * 1024 * 2;
constexpr size_t WS_YGELU = WS_VT + (size_t)TTOK * 512 * 2;
constexpr size_t WS_ATTN = WS_YGELU + (size_t)TTOK * 512 * 2;
constexpr size_t WS_XATTN = WS_ATTN + (size_t)TTOK * 512 * 2;
constexpr size_t WS_MERGED = WS_XATTN + (size_t)TTOK * 512 * 2;
constexpr size_t WS_MEMN = WS_MERGED + (size_t)TTOK * 1024 * 2;
constexpr size_t WS_KRAW = WS_MEMN + (size_t)512 * 1024 * 2;
constexpr size_t WS_VMT = WS_KRAW + (size_t)512 * 512 * 4;
constexpr size_t WS_S5S = WS_VMT + (size_t)512 * 512 * 2;
constexpr size_t WS_CARRY = WS_S5S + (size_t)512 * 32 * 128 * 4;
constexpr size_t WS_QN = WS_CARRY + (size_t)512 * 32 * 128 * 2;
constexpr size_t WS_KN = WS_QN + (size_t)TTOK * 512 * 2;
constexpr size_t WS_KMEAN = WS_KN + (size_t)TTOK * 512 * 2;
constexpr size_t WS_MLIST = WS_KMEAN + (size_t)16 * 64 * 64 * 4;
constexpr size_t WS_LPART = WS_MLIST + (size_t)16 * 516096 * 4;
constexpr size_t WS_KMEMN = WS_LPART + (size_t)TTOK * 8 * 4 * 4;
constexpr size_t WS_M_END = al256(WS_KMEMN + (size_t)512 * 512 * 2);
#define WS_MCNT (WS_CNT + 256)
constexpr size_t WS_H2 = WS_M0;
constexpr size_t WS_ACT = WS_H2 + (size_t)TTOK * 1024 * 2;
constexpr size_t WS_YSLOT = WS_ACT + (size_t)(TK_ROWS + 8192) * 1024 * 2;
constexpr size_t WS_LIST = WS_YSLOT + (size_t)TK_ROWS * 1024 * 2;
constexpr size_t WS_TOPW = WS_LIST + (size_t)32 * TTOK * 4;
constexpr size_t WS_E_END = al256(WS_TOPW + (size_t)TK_ROWS * 4);
constexpr size_t WS_END_A = (WS_M_END > WS_E_END ? WS_M_END : WS_E_END);

struct MP {
  const float* in[29];
  float* out;
  unsigned char* ws;
  int ph_lo, ph_hi;
};

#define LDS_GEMM_BYTES 131072
#define LDS_MISC_OFF 131072
#define LDS_TOTAL (131072 + 4096)

__device__ __forceinline__ int lds_byte(int r, int c) {
  int st = (r >> 4) * 2 + (c >> 5), rr = r & 15, cc = c & 31, ob = rr * 64 + cc * 2;
  return st * 1024 + (ob ^ (((ob >> 9) & 1) << 5));
}
__device__ __forceinline__ void stage_rc(int b, int& R, int& C) {
  int st = b / 1024, sb = b % 1024, swz = sb ^ (((sb >> 9) & 1) << 5);
  R = (st >> 1) * 16 + swz / 64;
  C = (st & 1) * 32 + (swz % 64) / 2;
}

#define WAIT_V(n) asm volatile("s_waitcnt vmcnt(" #n ")" ::: "memory")
#define WAIT_L(n) asm volatile("s_waitcnt lgkmcnt(" #n ")" ::: "memory")
#define BAR() do { asm volatile("" ::: "memory"); __builtin_amdgcn_s_barrier(); asm volatile("" ::: "memory"); } while (0)

typedef f32x4 acc_t[2][2][4][2];
template <class T> __device__ __forceinline__ T* opaque_ptr(T* q) { asm volatile("" : "+s"(q)); return q; }
__device__ __forceinline__ int opaque_tid() { int t = threadIdx.x; asm volatile("" : "+v"(t)); return t; }

#define LAS __attribute__((address_space(3)))
#define CAS __attribute__((address_space(4)))
__device__ __forceinline__ const CAS MP* kparams() {
  auto kp = __builtin_amdgcn_kernarg_segment_ptr();
  asm volatile("" : "+s"(kp));
  return (const CAS MP*)kp;
}
__device__ __forceinline__ MP kparams_load() {
  MP r{};
#if defined(__HIP_DEVICE_COMPILE__)
  const CAS MP* k = kparams();
#pragma unroll
  for (int i = 0; i < 29; ++i) r.in[i] = k->in[i];
  r.out = k->out; r.ws = k->ws; r.ph_lo = k->ph_lo; r.ph_hi = k->ph_hi;
#endif
  return r;
}

__device__ __forceinline__ int perm32(int rho) { const int n = rho >> 4, i = rho & 15; return 8 * (i >> 2) + 4 * n + (i & 3); }

struct OpLin {
  const char* base; unsigned voff[2]; long hstep; long kstep;
  __device__ __forceinline__ const char* ptr(int h, int i, int kt) const { return base + h * hstep + kt * kstep + voff[i]; }
};
struct OpGat {
  const char* base; unsigned voff[2][2]; long kstep;
  __device__ __forceinline__ const char* ptr(int h, int i, int kt) const { return base + kt * kstep + voff[h][i]; }
};
struct OpLin2 {
  OpLin s0, s1; int nt0;
  __device__ __forceinline__ const char* ptr(int h, int i, int kt) const { return kt < nt0 ? s0.ptr(h, i, kt) : s1.ptr(h, i, kt - nt0); }
};
__device__ __forceinline__ OpLin op_plain(int tid, const u16* mat, long row0, long ld, bool perm = false) {
  OpLin o;
  o.base = reinterpret_cast<const char*>(mat + row0 * ld);
#pragma unroll
  for (int i = 0; i < 2; ++i) {
    int R, C; stage_rc(tid * 16 + i * 8192, R, C);
    if (perm) R = (R & ~31) + perm32(R & 31);
    o.voff[i] = (unsigned)((R * ld + C) * 2);
  }
  o.hstep = 128 * ld * 2; o.kstep = 128;
  return o;
}

template <class OA, class OB>
__device__ __forceinline__ void gemm_unit(int tid, acc_t& acc, const OA& A, const OB& B, int nt) {
  extern __shared__ __attribute__((aligned(16))) unsigned char lds_raw[];
  LAS unsigned char* lds = (LAS unsigned char*)lds_raw;
  const int wid = __builtin_amdgcn_readfirstlane(tid >> 6), lane = tid & 63, wr = wid >> 2, wc = wid & 3,
            fr = lane & 15, fq = lane >> 4;
  const unsigned ldsw = (unsigned)wid * 1024u;
  const int aoff = lds_byte(wr * 64 + fr, fq * 8), boff = lds_byte(wc * 32 + fr, fq * 8);
#define HTB 16384
#define G_SA(b, h) (((b) * 2 + (h)) * HTB)
#define G_SB(b, h) ((4 + (b) * 2 + (h)) * HTB)
#define G_STAGE(bufoff, OP, h, kt)                                                                                  \
  do {                                                                                                              \
    _Pragma("unroll") for (int _i = 0; _i < 2; ++_i) __builtin_amdgcn_global_load_lds(                              \
        (const unsigned*)(OP).ptr((h), _i, (kt)), (LAS unsigned*)(lds + (bufoff) + ldsw + _i * 8192), 16, 0, 0);    \
  } while (0)
#define G_LDA(dst, b, h)                                                                                            \
  do {                                                                                                              \
    _Pragma("unroll") for (int m = 0; m < 4; ++m) _Pragma("unroll") for (int k = 0; k < 2; ++k) dst[m][k] =          \
        *(const LAS bf16x8*)(lds + G_SA(b, h) + aoff + m * 2048 + k * 1024);                                        \
  } while (0)
#define G_LDB(dst, b, h)                                                                                            \
  do {                                                                                                              \
    _Pragma("unroll") for (int n = 0; n < 2; ++n) _Pragma("unroll") for (int k = 0; k < 2; ++k) dst[n][k] =          \
        *(const LAS bf16x8*)(lds + G_SB(b, h) + boff + n * 2048 + k * 1024);                                        \
  } while (0)
#define G_MMA(ai, bj, At, Bt)                                                                                       \
  do {                                                                                                              \
    __builtin_amdgcn_s_setprio(1);                                                                                  \
    _Pragma("unroll") for (int m = 0; m < 4; ++m) _Pragma("unroll") for (int n = 0; n < 2; ++n)                     \
        _Pragma("unroll") for (int k = 0; k < 2; ++k) acc[ai][bj][m][n] =                                           \
            __builtin_amdgcn_mfma_f32_16x16x32_bf16(Bt[n][k], At[m][k], acc[ai][bj][m][n], 0, 0, 0);                \
    __builtin_amdgcn_s_setprio(0);                                                                                  \
  } while (0)
#define G_BAR __builtin_amdgcn_s_barrier()
#define G_SCHED __builtin_amdgcn_sched_barrier(0)
  bf16x8 At[4][2], B0[2][2], B1[2][2];
  G_STAGE(G_SB(0, 0), B, 0, 0); G_STAGE(G_SA(0, 0), A, 0, 0); G_STAGE(G_SB(0, 1), B, 1, 0); G_STAGE(G_SA(0, 1), A, 1, 0);
  if (wr == 1) G_BAR;
  WAIT_V(4); G_BAR;
  G_STAGE(G_SB(1, 0), B, 0, 1); G_STAGE(G_SA(1, 0), A, 0, 1); G_STAGE(G_SB(1, 1), B, 1, 1);
  WAIT_V(6); G_BAR;
  for (int t = 0; t < nt; t += 2) {
    const bool last = (t == nt - 2);
    const int k1 = t + 1, k2 = last ? 0 : t + 2, k3 = last ? 1 : t + 3;
    G_LDB(B0, 0, 0); G_SCHED; G_LDA(At, 0, 0); G_STAGE(G_SA(1, 1), A, 1, k1);
    WAIT_L(8); G_BAR; WAIT_L(0); G_MMA(0, 0, At, B0); G_BAR; G_SCHED;
    G_LDB(B1, 0, 1); G_STAGE(G_SB(0, 0), B, 0, k2);
    G_BAR; WAIT_L(0); G_MMA(0, 1, At, B1); G_BAR;
    G_LDA(At, 0, 1); G_STAGE(G_SA(0, 0), A, 0, k2);
    G_BAR; WAIT_L(0); G_MMA(1, 0, At, B0); G_BAR; G_SCHED;
    G_STAGE(G_SB(0, 1), B, 1, k2);
    WAIT_V(6); G_BAR; G_MMA(1, 1, At, B1); G_BAR;
    G_LDB(B0, 1, 0); G_SCHED; G_LDA(At, 1, 0); G_STAGE(G_SA(0, 1), A, 1, k2);
    WAIT_L(8); G_BAR; WAIT_L(0); G_MMA(0, 0, At, B0); G_BAR; G_SCHED;
    G_LDB(B1, 1, 1); G_STAGE(G_SB(1, 0), B, 0, k3);
    G_BAR; WAIT_L(0); G_MMA(0, 1, At, B1); G_BAR;
    G_LDA(At, 1, 1); G_STAGE(G_SA(1, 0), A, 0, k3);
    G_BAR; WAIT_L(0); G_MMA(1, 0, At, B0); G_BAR; G_SCHED;
    G_STAGE(G_SB(1, 1), B, 1, k3);
    WAIT_V(6); G_BAR; G_MMA(1, 1, At, B1); G_BAR;
  }
  WAIT_V(0);
  if (wr == 0) G_BAR;
  G_BAR;
#undef G_SA
#undef G_SB
#undef G_STAGE
#undef G_LDA
#undef G_LDB
#undef G_MMA
#undef G_BAR
#undef G_SCHED
}

__device__ __forceinline__ void acc_zero(acc_t& acc) {
#pragma unroll
  for (int a = 0; a < 2; ++a)
#pragma unroll
    for (int b = 0; b < 2; ++b)
#pragma unroll
      for (int m = 0; m < 4; ++m)
#pragma unroll
        for (int n = 0; n < 2; ++n) acc[a][b][m][n] = f32x4{0.f, 0.f, 0.f, 0.f};
}


__device__ __forceinline__ void unit_order(int Lin, int nM, int nN, int& pm, int& pn) {
  const int nwg = nM * nN;
  int wgid = Lin;
  { const int q = nwg / 8, r = nwg % 8, xcd = wgid % 8, off = wgid / 8; wgid = (xcd < r ? xcd * (q + 1) : r * (q + 1) + (xcd - r) * q) + off; }
  const int nig = 8 * nN, gid = wgid / nig, fm = gid * 8, gsz = (nM - fm) < 8 ? (nM - fm) : 8;
  pm = fm + ((wgid % nig) % gsz);
  pn = (wgid % nig) / gsz;
}
__device__ __forceinline__ float sigmoidf_(float x) { return __builtin_amdgcn_rcpf(1.f + __expf(-x)); }
__device__ __forceinline__ void unpack8(uint4 v, float (&f)[8]) {
  f[0] = __uint_as_float(v.x << 16); f[1] = __uint_as_float(v.x & 0xffff0000u);
  f[2] = __uint_as_float(v.y << 16); f[3] = __uint_as_float(v.y & 0xffff0000u);
  f[4] = __uint_as_float(v.z << 16); f[5] = __uint_as_float(v.z & 0xffff0000u);
  f[6] = __uint_as_float(v.w << 16); f[7] = __uint_as_float(v.w & 0xffff0000u);
}
__device__ __forceinline__ uint4 pack8(const float (&f)[8]) {
  uint4 o; o.x = pack2(f[0], f[1]); o.y = pack2(f[2], f[3]); o.z = pack2(f[4], f[5]); o.w = pack2(f[6], f[7]); return o;
}
enum { MAP_PERM = 0, MAP_GLU = 1 };
__device__ __forceinline__ int map_col(int np, int mode) {
  if (mode == MAP_PERM) return (np & ~31) + perm32(np & 31);
  int tile = np >> 8, s = np & 255, bj = s >> 7, rem = s & 127;
  return (bj ? 1024 : 0) + tile * 128 + (rem & ~31) + perm32(rem & 31);
}
__device__ __forceinline__ void transpose_tile(const float* __restrict__ src, int ldsrc, u16* __restrict__ dst, int K,
                                               int k0, int n0, int mode, int tid) {
  extern __shared__ __attribute__((aligned(16))) unsigned char lds_raw[];
  float* tl = reinterpret_cast<float*>(lds_raw);
#pragma unroll
  for (int i = 0; i < 2; ++i) {
    int k = (tid >> 4) + 32 * i, c4 = (tid & 15) * 4;
    int np = n0 + c4;
    int n = map_col(np, mode);
    float4 v = *reinterpret_cast<const float4*>(src + (long)(k0 + k) * ldsrc + n);
    tl[k * 65 + c4 + 0] = v.x; tl[k * 65 + c4 + 1] = v.y; tl[k * 65 + c4 + 2] = v.z; tl[k * 65 + c4 + 3] = v.w;
  }
  __syncthreads();
  {
    int kc = tid & 7, np = tid >> 3;
    unsigned int w[4];
#pragma unroll
    for (int i = 0; i < 4; ++i) w[i] = pack2(tl[(kc * 8 + 2 * i) * 65 + np], tl[(kc * 8 + 2 * i + 1) * 65 + np]);
    uint4 o; o.x = w[0]; o.y = w[1]; o.z = w[2]; o.w = w[3];
    *reinterpret_cast<uint4*>(dst + (long)(n0 + np) * K + k0 + kc * 8) = o;
  }
  __syncthreads();
}

__device__ void phase_prep_moe(const MP& p0) {
  const MP p = kparams_load(); (void)p0;
  const int tid0 = opaque_tid();
  const float* w_gu = p.in[25];
  const float* w_down = p.in[27];
  u16* wt_gu = reinterpret_cast<u16*>(p.ws + WS_WT_GU);
  u16* wt_down = reinterpret_cast<u16*>(p.ws + WS_WT_DOWN);
  const int n_gu = 32 * 512, n_down = 32 * 256;
  for (int t = blockIdx.x; t < n_gu + n_down; t += gridDim.x) {
    if (t < n_gu) {
      int e = t >> 9, r = t & 511, kt = r & 15, ntile = r >> 4;
      transpose_tile(w_gu + (size_t)e * 1024 * 2048, 2048, wt_gu + (size_t)e * 2048 * 1024, 1024, kt * 64, ntile * 64, MAP_GLU, tid0);
    } else {
      int tt = t - n_gu;
      int e = tt >> 8, r = tt & 255, kt = r & 15, ntile = r >> 4;
      transpose_tile(w_down + (size_t)e * 1024 * 1024, 1024, wt_down + (size_t)e * 1024 * 1024, 1024, kt * 64, ntile * 64, MAP_PERM, tid0);
    }
  }
  const float* g_ffn = p.in[22];
  const float* w_router = p.in[23];
  float* gw = reinterpret_cast<float*>(p.ws + WS_GW);
  for (int i = blockIdx.x * NTHR + tid0; i < 1024 * 32; i += gridDim.x * NTHR) gw[i] = g_ffn[i >> 5] * w_router[i];
  if (blockIdx.x == 0 && tid0 < 64) reinterpret_cast<int*>(p.ws + WS_CNT)[tid0] = 0;
}


__device__ __forceinline__ void rms_rows_bf16(const float* __restrict__ x, const float* __restrict__ g, u16* __restrict__ out,
                                              int nrows, int tid) {
  const int lane = tid & 63, gw = blockIdx.x * (NTHR / 64) + (tid >> 6), nw = gridDim.x * (NTHR / 64);
  for (int row = gw; row < nrows; row += nw) {
    const float* xr = x + (size_t)row * 1024;
    float4 v[4]; float ss = 0.f;
#pragma unroll
    for (int q = 0; q < 4; ++q) { v[q] = *reinterpret_cast<const float4*>(xr + q * 256 + lane * 4); ss += v[q].x * v[q].x + v[q].y * v[q].y + v[q].z * v[q].z + v[q].w * v[q].w; }
#pragma unroll
    for (int o = 32; o > 0; o >>= 1) ss += __shfl_xor(ss, o);
    const float r = rsqrtf(ss * (1.0f / 1024.0f) + 1e-6f);
#pragma unroll
    for (int q = 0; q < 4; ++q) {
      float4 gg = *reinterpret_cast<const float4*>(g + q * 256 + lane * 4);
      uint2 o2; o2.x = pack2(v[q].x * r * gg.x, v[q].y * r * gg.y); o2.y = pack2(v[q].z * r * gg.z, v[q].w * r * gg.w);
      *reinterpret_cast<uint2*>(out + (size_t)row * 1024 + q * 256 + lane * 4) = o2;
    }
  }
}

__device__ void s5_tables(const MP& p, int tid);
__device__ void rope_table(const MP& p, int tid);
__device__ void phase_prep_mix(const MP& p0) {
  const MP p = kparams_load(); (void)p0;
  const int tid0 = opaque_tid();
  const int n0 = 1408, n1 = n0 + 256, n2 = n1 + 128, n3 = n2 + 128, n4 = n3 + 256, n5 = n4 + 256;
  for (int t = blockIdx.x; t < n5; t += gridDim.x) {
    const float* src; u16* dst; int ldsrc, K, mode, r, kts;
    if (t < n0) { src = p.in[3]; dst = (u16*)(p.ws + WS_WT_IN); ldsrc = 5632; K = 1024; mode = MAP_PERM; r = t; kts = 16; }
    else if (t < n1) { src = p.in[12]; dst = (u16*)(p.ws + WS_WT_GLU); ldsrc = 2048; K = 512; mode = MAP_GLU; r = t - n0; kts = 8; }
    else if (t < n2) { src = p.in[15]; dst = (u16*)(p.ws + WS_WT_MO); ldsrc = 1024; K = 512; mode = MAP_PERM; r = t - n1; kts = 8; }
    else if (t < n3) { src = p.in[20]; dst = (u16*)(p.ws + WS_WT_CO); ldsrc = 1024; K = 512; mode = MAP_PERM; r = t - n2; kts = 8; }
    else if (t < n4) { src = p.in[21]; dst = (u16*)(p.ws + WS_WT_OUT); ldsrc = 1024; K = 1024; mode = MAP_PERM; r = t - n3; kts = 16; }
    else { src = p.in[17]; dst = (u16*)(p.ws + WS_WT_KV); ldsrc = 1024; K = 1024; mode = MAP_PERM; r = t - n4; kts = 16; }
    const int kt = r % kts, ntile = r / kts;
    transpose_tile(src, ldsrc, dst, K, kt * 64, ntile * 64, mode, tid0);
  }
  rms_rows_bf16(p.in[0], p.in[2], (u16*)(p.ws + WS_H), TTOK, tid0);
  rms_rows_bf16(p.in[1], p.in[16], (u16*)(p.ws + WS_MEMN), 512, tid0);
  s5_tables(p, tid0);
  rope_table(p, tid0);
  for (int i = blockIdx.x * NTHR + tid0; i < 1024; i += gridDim.x * NTHR) reinterpret_cast<int*>(p.ws + WS_MCNT)[i] = 0;
}

__device__ void phase_gemm1(const MP& p0) {
  const MP p = kparams_load(); (void)p0;
  const u16* hb = (const u16*)(p.ws + WS_H);
  const u16* wt_in = (const u16*)(p.ws + WS_WT_IN);
  const int n_main = 128 * 20, n_vt = 2 * 128, n_kv = 8;
  for (int unit = blockIdx.x; unit < n_main + n_vt + n_kv; unit += gridDim.x) {
    const int tid = opaque_tid();
    acc_t acc;
    acc_zero(acc);
    if (unit < n_main) {
      int pm, pn;
      unit_order(unit, 128, 20, pm, pn);
      if (pn >= 6) pn += 2;
      OpLin A = op_plain(tid, hb, (long)pm * 256, 1024);
      OpLin B = op_plain(tid, wt_in, (long)pn * 256, 1024);
      gemm_unit(tid, acc, A, B, 16);
      const int te = opaque_tid(), wr = (te >> 8) & 1, wc = (te >> 6) & 3, fr = te & 15, fq = (te >> 4) & 3;
      u16* proj = (u16*)(p.ws + WS_PROJ);
#pragma unroll
      for (int ai = 0; ai < 2; ++ai)
#pragma unroll
        for (int m = 0; m < 4; ++m) {
          const size_t row = (size_t)pm * 256 + ai * 128 + wr * 64 + m * 16 + fr;
#pragma unroll
          for (int bj = 0; bj < 2; ++bj) {
            const int col = pn * 256 + bj * 128 + wc * 32 + fq * 8;
            uint4 o;
            o.x = pack2(acc[ai][bj][m][0][0], acc[ai][bj][m][0][1]); o.y = pack2(acc[ai][bj][m][0][2], acc[ai][bj][m][0][3]);
            o.z = pack2(acc[ai][bj][m][1][0], acc[ai][bj][m][1][1]); o.w = pack2(acc[ai][bj][m][1][2], acc[ai][bj][m][1][3]);
            *reinterpret_cast<uint4*>(proj + row * 5632 + col) = o;
          }
        }
    } else if (unit < n_main + n_vt) {
      const int u2 = unit - n_main, pm = u2 & 1, pn = u2 >> 1;
      OpLin A = op_plain(tid, wt_in, (long)1536 + pm * 256, 1024);
      OpLin B = op_plain(tid, hb, (long)pn * 256, 1024, true);
      gemm_unit(tid, acc, A, B, 16);
      const int te = opaque_tid(), wr = (te >> 8) & 1, wc = (te >> 6) & 3, fr = te & 15, fq = (te >> 4) & 3;
      u16* vt = (u16*)(p.ws + WS_VT);
      const int tok0 = pn * 256, bb = tok0 / SEQ, l0 = tok0 % SEQ;
#pragma unroll
      for (int ai = 0; ai < 2; ++ai)
#pragma unroll
        for (int m = 0; m < 4; ++m) {
          const int dslot = pm * 256 + ai * 128 + wr * 64 + m * 16 + fr;
          const int dg = (dslot & ~31) + perm32(dslot & 31);
          u16* vrow = vt + ((size_t)bb * 512 + dg) * SEQ + l0;
#pragma unroll
          for (int bj = 0; bj < 2; ++bj) {
            const int col = bj * 128 + wc * 32 + fq * 8;
            uint4 o;
            o.x = pack2(acc[ai][bj][m][0][0], acc[ai][bj][m][0][1]); o.y = pack2(acc[ai][bj][m][0][2], acc[ai][bj][m][0][3]);
            o.z = pack2(acc[ai][bj][m][1][0], acc[ai][bj][m][1][1]); o.w = pack2(acc[ai][bj][m][1][2], acc[ai][bj][m][1][3]);
            *reinterpret_cast<uint4*>(vrow + col) = o;
          }
        }
    } else {
      const int u3 = unit - n_main - n_vt, pm = u3 & 1, pn = u3 >> 1;
      OpLin A = op_plain(tid, (const u16*)(p.ws + WS_MEMN), (long)pm * 256, 1024);
      OpLin B = op_plain(tid, (const u16*)(p.ws + WS_WT_KV), (long)pn * 256, 1024);
      gemm_unit(tid, acc, A, B, 16);
      const int te = opaque_tid(), wr = (te >> 8) & 1, wc = (te >> 6) & 3, fr = te & 15, fq = (te >> 4) & 3;
      float* kraw = (float*)(p.ws + WS_KRAW);
      u16* vmt = (u16*)(p.ws + WS_VMT);
#pragma unroll
      for (int ai = 0; ai < 2; ++ai)
#pragma unroll
        for (int m = 0; m < 4; ++m) {
          const int row = pm * 256 + ai * 128 + wr * 64 + m * 16 + fr;
#pragma unroll
          for (int bj = 0; bj < 2; ++bj)
#pragma unroll
            for (int n = 0; n < 2; ++n)
#pragma unroll
              for (int j = 0; j < 4; ++j) {
                const int col = pn * 256 + bj * 128 + wc * 32 + fq * 8 + n * 4 + j;
                const float v = acc[ai][bj][m][n][j];
                if (col < 512) kraw[row * 512 + col] = v;
                else { const int c2 = col - 512; vmt[(((size_t)(row >> 8) * 4 + (c2 >> 7)) * 128 + (c2 & 127)) * 256 + (row & 255)] = f2bf(v); }
              }
        }
    }
  }
}


__device__ void s5_tables(const MP& p, int tid) {
  extern __shared__ __attribute__((aligned(16))) unsigned char lds_raw[];
  float* apr = reinterpret_cast<float*>(lds_raw);
  float* api = apr + 64;
  float* wr_ = api + 64;
  float* wi_ = wr_ + 1024;
  const float* lam_re = p.in[4]; const float* lam_im = p.in[5]; const float* log_dt = p.in[6];
  const float* b_re = p.in[7]; const float* b_im = p.in[8]; const float* c_re = p.in[9]; const float* c_im = p.in[10];
  u16* KT = (u16*)(p.ws + WS_KT); u16* FT = (u16*)(p.ws + WS_FT); u16* ET = (u16*)(p.ws + WS_ET);
  float* A64 = (float*)(p.ws + WS_A64);
  for (int task = blockIdx.x; task < 32 * 65; task += gridDim.x) {
    const int g = task / 65, dl = task % 65;
    __syncthreads();
    if (tid < 64) {
      const int i = g * 64 + tid;
      const float dt = expf(log_dt[g]);
      const float lr = lam_re[i], li = lam_im[i];
      const float mag = expf(lr * dt);
      float sn, cs; sincos_acc(li * dt, sn, cs);
      const float a_r = mag * cs, a_i = mag * sn;
      float pr = 1.f, pi = 0.f;
      for (int k = 0; k < dl; ++k) { float nr = pr * a_r - pi * a_i; pi = pr * a_i + pi * a_r; pr = nr; }
      apr[tid] = pr; api[tid] = pi;
    }
    __syncthreads();
    for (int e = tid; e < 1024; e += NTHR) {
      const int pp = e >> 4;
      const int i = g * 64 + pp;
      const float dt = expf(log_dt[g]);
      const float lr = lam_re[i], li = lam_im[i];
      const float mag = expf(lr * dt);
      float sn, cs; sincos_acc(li * dt, sn, cs);
      const float a_r = mag * cs, a_i = mag * sn;
      const float nr = a_r - 1.0f, den = lr * lr + li * li;
      const float cr = (nr * lr + a_i * li) / den, ci = (a_i * lr - nr * li) / den;
      const float br = b_re[(size_t)i * 16 + (e & 15)], bi = b_im[(size_t)i * 16 + (e & 15)];
      const float bbr = cr * br - ci * bi, bbi = cr * bi + ci * br;
      wr_[e] = apr[pp] * bbr - api[pp] * bbi;
      wi_[e] = apr[pp] * bbi + api[pp] * bbr;
    }
    __syncthreads();
    if (dl <= 63) {
      if (tid < 256) {
        const int ho = tid >> 4, hi = tid & 15;
        const float* cre = c_re + ((size_t)g * 16 + ho) * 64;
        const float* cim = c_im + ((size_t)g * 16 + ho) * 64;
        float acc = 0.f;
        for (int pp = 0; pp < 64; ++pp) acc += cre[pp] * wr_[pp * 16 + hi] - cim[pp] * wi_[pp * 16 + hi];
        KT[((size_t)g * 127 + dl + 63) * 256 + tid] = f2bf(acc);
        if (dl <= 62) KT[((size_t)g * 127 + 62 - dl) * 256 + tid] = 0;
      }
      const int tau = 63 - dl;
      for (int e = tid; e < 2048; e += NTHR) {
        const int n = e >> 4, hi = e & 15, c = n >> 6, pp = n & 63;
        FT[((size_t)g * 128 + n) * 1024 + tau * 16 + hi] = f2bf(c ? wi_[pp * 16 + hi] : wr_[pp * 16 + hi]);
      }
    }
    if (dl >= 1) {
      const int t = dl - 1;
      for (int e = tid; e < 2048; e += NTHR) {
        const int ho = e >> 7, k = e & 127, c = k >> 6, pp = k & 63;
        const float cre = c_re[((size_t)g * 16 + ho) * 64 + pp], cim = c_im[((size_t)g * 16 + ho) * 64 + pp];
        const float v = c ? -(cre * api[pp] + cim * apr[pp]) : (cre * apr[pp] - cim * api[pp]);
        ET[((size_t)g * 1024 + t * 16 + ho) * 128 + k] = f2bf(v);
      }
    }
    if (dl == 64 && tid < 64) { A64[(g * 64 + tid) * 2] = apr[tid]; A64[(g * 64 + tid) * 2 + 1] = api[tid]; }
  }
}

__device__ __forceinline__ OpLin op_u(int tid, const u16* proj, int g, int pm) {
  OpLin o;
  o.base = reinterpret_cast<const char*>(proj + (size_t)pm * 256 * 64 * 5632 + g * 16);
#pragma unroll
  for (int i = 0; i < 2; ++i) { int R, C; stage_rc(tid * 16 + i * 8192, R, C); o.voff[i] = (unsigned)((R * 64 * 5632 + (C >> 4) * 5632 + (C & 15)) * 2); }
  o.hstep = (long)128 * 64 * 5632 * 2; o.kstep = 4 * 5632 * 2;
  return o;
}

__device__ void phase_s5s(const MP& p0) {
  const MP p = kparams_load(); (void)p0;
  for (int unit = blockIdx.x; unit < 64; unit += gridDim.x) {
    const int tid = opaque_tid();
    const int g = unit >> 1, pm = unit & 1;
    acc_t acc;
    acc_zero(acc);
    OpLin A = op_u(tid, (const u16*)(p.ws + WS_PROJ), g, pm);
    OpLin B = op_plain(tid, (const u16*)(p.ws + WS_FT) + (size_t)g * 128 * 1024, 0, 1024);
    B.hstep = 0;
    gemm_unit(tid, acc, A, B, 16);
    const int te = opaque_tid(), wr = (te >> 8) & 1, wc = (te >> 6) & 3, fr = te & 15, fq = (te >> 4) & 3;
    float* S = (float*)(p.ws + WS_S5S);
#pragma unroll
    for (int ai = 0; ai < 2; ++ai)
#pragma unroll
      for (int m = 0; m < 4; ++m) {
        const size_t chunk = (size_t)pm * 256 + ai * 128 + wr * 64 + m * 16 + fr;
#pragma unroll
        for (int n = 0; n < 2; ++n) {
          const int col = wc * 32 + n * 16 + fq * 4;
          float4 o = make_float4(acc[ai][0][m][n][0], acc[ai][0][m][n][1], acc[ai][0][m][n][2], acc[ai][0][m][n][3]);
          *reinterpret_cast<float4*>(S + (chunk * 32 + g) * 128 + col) = o;
        }
      }
  }
}

__device__ void phase_s5scan(const MP& p0) {
  const MP p = kparams_load(); (void)p0;
  const int tid = opaque_tid();
  if (blockIdx.x >= 8) return;
  const int id = blockIdx.x * NTHR + tid, pp = id & 63, g = (id >> 6) & 31, b = id >> 11;
  const float* S = (const float*)(p.ws + WS_S5S);
  u16* CR = (u16*)(p.ws + WS_CARRY);
  const float* A64 = (const float*)(p.ws + WS_A64);
  const float ar = A64[(g * 64 + pp) * 2], ai = A64[(g * 64 + pp) * 2 + 1];
  float cr = 0.f, ci = 0.f;
  for (int c0 = 0; c0 < 256; c0 += 8) {
    float sr[8], si[8];
#pragma unroll
    for (int j = 0; j < 8; ++j) {
      const size_t base = (((size_t)b * 256 + c0 + j) * 32 + g) * 128;
      sr[j] = S[base + pp]; si[j] = S[base + 64 + pp];
    }
#pragma unroll
    for (int j = 0; j < 8; ++j) {
      const size_t base = (((size_t)b * 256 + c0 + j) * 32 + g) * 128;
      CR[base + pp] = f2bf(cr); CR[base + 64 + pp] = f2bf(ci);
      const float nr = ar * cr - ai * ci + sr[j];
      ci = ar * ci + ai * cr + si[j];
      cr = nr;
    }
  }
}

__device__ void phase_s5y(const MP& p0) {
  const MP p = kparams_load(); (void)p0;
  for (int unit = blockIdx.x; unit < 256; unit += gridDim.x) {
    const int tid = opaque_tid();
    const int g = unit >> 3, pm = (unit >> 2) & 1, pn = unit & 3;
    acc_t acc;
    acc_zero(acc);
    {
      OpLin A = op_u(tid, (const u16*)(p.ws + WS_PROJ), g, pm);
      OpLin B;
      B.base = reinterpret_cast<const char*>((const u16*)(p.ws + WS_KT) + (size_t)g * 127 * 256) + ((pn * 16 + 63) * 256) * 2 - 3 * 512;
#pragma unroll
      for (int i = 0; i < 2; ++i) { int R, C; stage_rc(tid * 16 + i * 8192, R, C); B.voff[i] = (unsigned)(((R >> 4) * 256 + (R & 15) * 16) * 2 + (3 - (C >> 4)) * 512 + (C & 15) * 2); }
      B.hstep = 4096; B.kstep = -2048;
      gemm_unit(tid, acc, A, B, 4 * (pn + 1));
    }
#ifndef S5Y_NOSEG2
    {
      const int tid2 = opaque_tid();
      OpLin A;
      A.base = reinterpret_cast<const char*>((const u16*)(p.ws + WS_CARRY) + ((size_t)pm * 256 * 32 + g) * 128);
#pragma unroll
      for (int i = 0; i < 2; ++i) { int R, C; stage_rc(tid2 * 16 + i * 8192, R, C); A.voff[i] = (unsigned)((R * 32 * 128 + C) * 2); }
      A.hstep = (long)128 * 32 * 128 * 2; A.kstep = 128;
      OpLin B = op_plain(tid2, (const u16*)(p.ws + WS_ET) + (size_t)g * 1024 * 128, (long)pn * 256, 128);
      gemm_unit(tid2, acc, A, B, 2);
    }
#endif
    const int te = opaque_tid(), wr = (te >> 8) & 1, wc = (te >> 6) & 3, fr = te & 15, fq = (te >> 4) & 3;
    const u16* proj = (const u16*)(p.ws + WS_PROJ);
    u16* yg = (u16*)(p.ws + WS_YGELU);
    const float4 dsk = *reinterpret_cast<const float4*>(p.in[11] + g * 16 + fq * 4);
#pragma unroll
    for (int ai = 0; ai < 2; ++ai)
#pragma unroll
      for (int m = 0; m < 4; ++m) {
        const size_t chunk = (size_t)pm * 256 + ai * 128 + wr * 64 + m * 16 + fr;
#pragma unroll
        for (int bj = 0; bj < 2; ++bj)
#pragma unroll
          for (int n = 0; n < 2; ++n) {
            const int t = pn * 16 + bj * 8 + wc * 2 + n;
            const size_t tok = chunk * 64 + t;
            const uint2 uu = *reinterpret_cast<const uint2*>(proj + tok * 5632 + g * 16 + fq * 4);
            float y[4];
            y[0] = acc[ai][bj][m][n][0] + dsk.x * __uint_as_float(uu.x << 16);
            y[1] = acc[ai][bj][m][n][1] + dsk.y * __uint_as_float(uu.x & 0xffff0000u);
            y[2] = acc[ai][bj][m][n][2] + dsk.z * __uint_as_float(uu.y << 16);
            y[3] = acc[ai][bj][m][n][3] + dsk.w * __uint_as_float(uu.y & 0xffff0000u);
#pragma unroll
            for (int j = 0; j < 4; ++j) {
              const float v = y[j];
              const float inner = 0.7978845608028654f * (v + 0.044715f * v * v * v);
              const float th = 1.0f - 2.0f * __builtin_amdgcn_rcpf(__expf(2.0f * inner) + 1.0f);
              y[j] = 0.5f * v * (1.0f + th);
            }
            uint2 o; o.x = pack2(y[0], y[1]); o.y = pack2(y[2], y[3]);
            *reinterpret_cast<uint2*>(yg + tok * 512 + g * 16 + fq * 4) = o;
          }
        asm volatile("" ::: "memory");
      }
  }
}


__device__ void rope_table(const MP& p, int tid) {
  float* rope = (float*)(p.ws + WS_ROPE);
  for (int i = blockIdx.x * NTHR + tid; i < SEQ * 32; i += gridDim.x * NTHR) {
    const int t = i >> 5, d = i & 31;
    const float inv = (float)pow(10000.0, -(double)d / 32.0);
    const float ang = (float)t * inv;
    float sn, cs; sincos_acc(ang, sn, cs);
    rope[(size_t)t * 64 + d] = cs;
    rope[(size_t)t * 64 + 32 + d] = sn;
  }
}

__device__ __forceinline__ void head_norm_rope(const u16* __restrict__ src, const float* __restrict__ gg,
                                               const float* __restrict__ rp, float (&v)[64]) {
  float ss = 0.f;
#pragma unroll
  for (int c = 0; c < 8; ++c) {
    float f[8];
    unpack8(*reinterpret_cast<const uint4*>(src + c * 8), f);
#pragma unroll
    for (int j = 0; j < 8; ++j) { v[c * 8 + j] = f[j]; ss += f[j] * f[j]; }
  }
  const float r = rsqrtf(ss * (1.0f / 64.0f) + 1e-6f);
#pragma unroll
  for (int d = 0; d < 64; ++d) v[d] = v[d] * r * gg[d];
#pragma unroll
  for (int d = 0; d < 32; ++d) {
    const float cs = rp[d], sn = rp[32 + d];
    const float x1 = v[d], x2 = v[d + 32];
    v[d] = x1 * cs - x2 * sn;
    v[d + 32] = x2 * cs + x1 * sn;
  }
}
__device__ __forceinline__ void store_row64_bf16(u16* dst, const float (&v)[64]) {
#pragma unroll
  for (int c = 0; c < 8; ++c) {
    float f[8];
#pragma unroll
    for (int j = 0; j < 8; ++j) f[j] = v[c * 8 + j];
    *reinterpret_cast<uint4*>(dst + c * 8) = pack8(f);
  }
}

__device__ void phase_kprep(const MP& p0) {
  extern __shared__ __attribute__((aligned(16))) unsigned char lds_raw[];
  const MP p = kparams_load(); (void)p0;
  const int tid = opaque_tid();
  float* kl = reinterpret_cast<float*>(lds_raw);
  float* part = kl + 256 * 65;
  const u16* proj = (const u16*)(p.ws + WS_PROJ);
  const float* rope = (const float*)(p.ws + WS_ROPE);
  u16* knb = (u16*)(p.ws + WS_KN);
  float* kmean = (float*)(p.ws + WS_KMEAN);
  for (int task = blockIdx.x; task < 16 * 32; task += gridDim.x) {
    const int bh = task >> 5, blk = (task & 31) * 2 + (tid >> 8), b = bh >> 3, h = bh & 7;
    const int t = blk * 256 + (tid & 255);
    float v[64];
    head_norm_rope(proj + ((size_t)b * SEQ + t) * 5632 + 1024 + h * 64, p.in[14], rope + (size_t)t * 64, v);
    store_row64_bf16(knb + ((size_t)bh * SEQ + t) * 64, v);
#pragma unroll 1
    for (int rnd = 0; rnd < 2; ++rnd) {
      __syncthreads();
      if ((tid >> 8) == rnd) {
#pragma unroll
        for (int d = 0; d < 64; ++d) kl[(tid & 255) * 65 + d] = v[d];
      }
      __syncthreads();
      {
        const int d = tid & 63, pt = tid >> 6;
        float sum = 0.f;
        for (int i = 0; i < 32; ++i) sum += kl[(pt * 32 + i) * 65 + d];
        part[pt * 64 + d] = sum;
      }
      __syncthreads();
      if (tid < 64) {
        float sum = 0.f;
#pragma unroll
        for (int i = 0; i < 8; ++i) sum += part[i * 64 + tid];
        kmean[((size_t)bh * 64 + (task & 31) * 2 + rnd) * 64 + tid] = sum * (1.0f / 256.0f);
      }
    }
  }
  {
    const float* kraw = (const float*)(p.ws + WS_KRAW);
    const float* g_ck = p.in[19];
    u16* kmn = (u16*)(p.ws + WS_KMEMN);
    for (int i = blockIdx.x * NTHR + tid; i < 512 * 4 * 16; i += gridDim.x * NTHR) {
      const int sub = i & 15, rx = i >> 4, xh = rx & 3, row = rx >> 2;
      const float* src = kraw + (size_t)row * 512 + xh * 128 + sub * 8;
      float4 a = *reinterpret_cast<const float4*>(src), c = *reinterpret_cast<const float4*>(src + 4);
      float ss = a.x * a.x + a.y * a.y + a.z * a.z + a.w * a.w + c.x * c.x + c.y * c.y + c.z * c.z + c.w * c.w;
      ss += __shfl_xor(ss, 1); ss += __shfl_xor(ss, 2); ss += __shfl_xor(ss, 4); ss += __shfl_xor(ss, 8);
      const float r = rsqrtf(ss * (1.0f / 128.0f) + 1e-6f);
      const float* g = g_ck + sub * 8;
      float f[8] = {a.x * r * g[0], a.y * r * g[1], a.z * r * g[2], a.w * r * g[3], c.x * r * g[4], c.y * r * g[5], c.z * r * g[6], c.w * r * g[7]};
      *reinterpret_cast<uint4*>(kmn + (((size_t)(row >> 8) * 4 + xh) * 256 + (row & 255)) * 128 + sub * 8) = pack8(f);
    }
  }
}

__device__ __forceinline__ int mlist_off(int j) { return j * SEQ - 128 * j * (j + 1); }

__device__ void phase_gate(const MP& p0) {
  extern __shared__ __attribute__((aligned(16))) unsigned char lds_raw[];
  const MP p = kparams_load(); (void)p0;
  const int tid = opaque_tid();
  float* km = reinterpret_cast<float*>(lds_raw);
  int* hist = reinterpret_cast<int*>(km + 4096);
  int* gbase = hist + 64;
  const u16* proj = (const u16*)(p.ws + WS_PROJ);
  const float* rope = (const float*)(p.ws + WS_ROPE);
  u16* qnb = (u16*)(p.ws + WS_QN);
  const float* kmean = (const float*)(p.ws + WS_KMEAN);
  int* mcnt = (int*)(p.ws + WS_MCNT);
  int* mlist = (int*)(p.ws + WS_MLIST);
  for (int task = blockIdx.x; task < 16 * 32; task += gridDim.x) {
    const int bh = task >> 5, c512 = task & 31, b = bh >> 3, h = bh & 7;
    const int t = c512 * 512 + tid, qblk = t >> 8;
    const int nblk = c512 * 2 + 1;
    __syncthreads();
    for (int i = tid; i < nblk * 64; i += NTHR) km[i] = kmean[(size_t)bh * 4096 + i];
    if (tid < 64) hist[tid] = 0;
    __syncthreads();
    float q[64];
    head_norm_rope(proj + ((size_t)b * SEQ + t) * 5632 + 512 + h * 64, p.in[13], rope + (size_t)t * 64, q);
    store_row64_bf16(qnb + ((size_t)bh * SEQ + t) * 64, q);
    float tv0 = -INFINITY, tv1 = -INFINITY, tv2 = -INFINITY;
    int ti0 = -1, ti1 = -1, ti2 = -1;
    for (int j = 0; j < qblk; ++j) {
      const float* kj = km + j * 64;
      float sacc = 0.f;
#pragma unroll
      for (int d = 0; d < 64; ++d) sacc = fmaf(q[d], kj[d], sacc);
      if (sacc > tv0) { tv2 = tv1; ti2 = ti1; tv1 = tv0; ti1 = ti0; tv0 = sacc; ti0 = j; }
      else if (sacc > tv1) { tv2 = tv1; ti2 = ti1; tv1 = sacc; ti1 = j; }
      else if (sacc > tv2) { tv2 = sacc; ti2 = j; }
    }
    int lp0 = 0, lp1 = 0, lp2 = 0;
    if (ti0 >= 0) lp0 = atomicAdd(&hist[ti0], 1);
    if (ti1 >= 0) lp1 = atomicAdd(&hist[ti1], 1);
    if (ti2 >= 0) lp2 = atomicAdd(&hist[ti2], 1);
    __syncthreads();
    if (tid < 64) gbase[tid] = hist[tid] ? atomicAdd(&mcnt[bh * 64 + tid], hist[tid]) : 0;
    __syncthreads();
    int* lb = mlist + (size_t)bh * 516096;
    if (ti0 >= 0) lb[mlist_off(ti0) + gbase[ti0] + lp0] = t * 4 + 0;
    if (ti1 >= 0) lb[mlist_off(ti1) + gbase[ti1] + lp1] = t * 4 + 1;
    if (ti2 >= 0) lb[mlist_off(ti2) + gbase[ti2] + lp2] = t * 4 + 2;
  }
}

template <int DH, int NK>
__device__ __forceinline__ void attn_wave(LAS const unsigned char* ldsK, LAS const unsigned char* ldsVT,
                                          const bf16x8 (&qf)[DH / 32], int npairs, int causal_qpos, float c1, float c2,
                                          f32x4 (&o)[DH / 16], float& lsum, int fr, int fq) {
  constexpr int KROW = (DH + 8) * 2, VROW = (NK + 8) * 2;
#pragma unroll 1
  for (int i = 0; i < NK / 32; ++i) {
    if (i < npairs) {
      f32x4 s0 = {0.f, 0.f, 0.f, 0.f}, s1 = {0.f, 0.f, 0.f, 0.f};
#pragma unroll
      for (int ks = 0; ks < DH / 32; ++ks) {
        const bf16x8 k0 = *(const LAS bf16x8*)(ldsK + ((2 * i) * 16 + fr) * KROW + (ks * 32 + fq * 8) * 2);
        const bf16x8 k1 = *(const LAS bf16x8*)(ldsK + ((2 * i + 1) * 16 + fr) * KROW + (ks * 32 + fq * 8) * 2);
        s0 = __builtin_amdgcn_mfma_f32_16x16x32_bf16(k0, qf[ks], s0, 0, 0, 0);
        s1 = __builtin_amdgcn_mfma_f32_16x16x32_bf16(k1, qf[ks], s1, 0, 0, 0);
      }
      float pv[8];
#pragma unroll
      for (int r = 0; r < 4; ++r) {
        pv[r] = __builtin_amdgcn_exp2f(fmaf(s0[r], c1, -c2));
        pv[4 + r] = __builtin_amdgcn_exp2f(fmaf(s1[r], c1, -c2));
      }
      if (causal_qpos >= 0) {
#pragma unroll
        for (int r = 0; r < 4; ++r) {
          if (32 * i + 4 * fq + r > causal_qpos) pv[r] = 0.f;
          if (32 * i + 16 + 4 * fq + r > causal_qpos) pv[4 + r] = 0.f;
        }
      }
#pragma unroll
      for (int r = 0; r < 8; ++r) lsum += pv[r];
      union { bf16x8 v; unsigned int u[4]; } pf;
      pf.u[0] = pack2(pv[0], pv[1]); pf.u[1] = pack2(pv[2], pv[3]); pf.u[2] = pack2(pv[4], pv[5]); pf.u[3] = pack2(pv[6], pv[7]);
#pragma unroll
      for (int ds = 0; ds < DH / 16; ++ds) {
        union { bf16x8 v; u32x2 h[2]; } vf;
        vf.h[0] = *(const LAS u32x2*)(ldsVT + (ds * 16 + fr) * VROW + (32 * i + 4 * fq) * 2);
        vf.h[1] = *(const LAS u32x2*)(ldsVT + (ds * 16 + fr) * VROW + (32 * i + 16 + 4 * fq) * 2);
        o[ds] = __builtin_amdgcn_mfma_f32_16x16x32_bf16(vf.v, pf.v, o[ds], 0, 0, 0);
      }
    }
  }
}

__device__ void phase_moba(const MP& p0) {
  extern __shared__ __attribute__((aligned(16))) unsigned char lds_raw[];
  const MP p = kparams_load(); (void)p0;
  const int tid = opaque_tid();
  LAS unsigned char* lds = (LAS unsigned char*)lds_raw;
  constexpr int K_OFF = 0, VT_OFF = 256 * 144, PFX_OFF = VT_OFF + 64 * 528;
  int* pfx = reinterpret_cast<int*>(lds_raw + PFX_OFF);
  float* misc = reinterpret_cast<float*>(lds_raw + PFX_OFF + 1032 * 4);
  const u16* qn = (const u16*)(p.ws + WS_QN);
  const u16* kn = (const u16*)(p.ws + WS_KN);
  const u16* vt = (const u16*)(p.ws + WS_VT);
  const int* mcnt = (const int*)(p.ws + WS_MCNT);
  const int* mlist = (const int*)(p.ws + WS_MLIST);
  u16* opart = (u16*)p.out;
  float* lpart = (float*)(p.ws + WS_LPART);
  const int wid = tid >> 6, lane = tid & 63, fr = lane & 15, fq = lane >> 4;
  if (tid < 64) {
    float mq = fabsf(p.in[13][tid]), mk = fabsf(p.in[14][tid]);
#pragma unroll
    for (int o = 32; o > 0; o >>= 1) { mq = fmaxf(mq, __shfl_xor(mq, o)); mk = fmaxf(mk, __shfl_xor(mk, o)); }
    if (tid == 0) misc[0] = 8.0f * mq * mk * 1.02f;
  }
  {
    const int a = (mcnt[2 * tid] + 127) >> 7, b = (mcnt[2 * tid + 1] + 127) >> 7;
    int x = a + b;
#pragma unroll
    for (int o = 1; o < 64; o <<= 1) { const int y = __shfl_up(x, o); if (lane >= o) x += y; }
    int* wsum = reinterpret_cast<int*>(misc + 4);
    if (lane == 63) wsum[wid] = x;
    __syncthreads();
    int base = 0;
    for (int w = 0; w < wid; ++w) base += wsum[w];
    const int incl = base + x;
    pfx[1 + 2 * tid] = incl - b; pfx[2 + 2 * tid] = incl;
    if (tid == 0) pfx[0] = 0;
    __syncthreads();
  }
  const float c1 = 0.125f * 1.4426950408889634f, c2 = misc[0] * 1.4426950408889634f;
  const int n_own = 16 * 64 * 2, n_sel = pfx[1024];
  for (int item = blockIdx.x; item < n_own + n_sel; item += gridDim.x) {
    int bh, kblk, nkeys, slot_own, q0 = 0, cnt = 0, ltile = 0;
    const int* lptr = nullptr;
    if (item < n_own) {
      bh = item >> 7; kblk = (item >> 1) & 63; const int half = item & 1;
      nkeys = (half + 1) * 128; q0 = kblk * 256 + half * 128; slot_own = 1;
    } else {
      const int it = item - n_own;
      int lo = 0, hi = 1024;
      while (hi - lo > 1) { const int mid = (lo + hi) >> 1; if (pfx[mid] <= it) lo = mid; else hi = mid; }
      bh = lo >> 6; kblk = lo & 63; ltile = it - pfx[lo]; cnt = mcnt[lo];
      lptr = mlist + (size_t)bh * 516096 + mlist_off(kblk) + ltile * 128;
      cnt -= ltile * 128;
      nkeys = 256; slot_own = 0;
    }
    __syncthreads();
    {
      const u16* kb = kn + ((size_t)bh * SEQ + (size_t)kblk * 256) * 64;
#pragma unroll
      for (int i = 0; i < 4; ++i) {
        const int key = (tid >> 3) + 64 * i, ch = tid & 7;
        if (key < nkeys) *(LAS u32x4*)(lds + K_OFF + key * 144 + ch * 16) = *reinterpret_cast<const u32x4*>(kb + (size_t)key * 64 + ch * 8);
      }
      const u16* vb = vt + (size_t)bh * 64 * SEQ + (size_t)kblk * 256;
#pragma unroll
      for (int i = 0; i < 4; ++i) {
        const int d = (tid >> 5) + 16 * i, ch = tid & 31;
        if (ch * 8 < nkeys) *(LAS u32x4*)(lds + VT_OFF + d * 528 + ch * 16) = *reinterpret_cast<const u32x4*>(vb + (size_t)d * SEQ + ch * 8);
      }
    }
    int tq, slot, valid = 1;
    if (slot_own) { tq = q0 + wid * 16 + fr; slot = 3; }
    else { const int idx = wid * 16 + fr; valid = idx < cnt; const int ent = lptr[valid ? idx : 0]; tq = ent >> 2; slot = ent & 3; }
    bf16x8 qf[2];
    {
      const u16* qp = qn + ((size_t)bh * SEQ + tq) * 64 + fq * 8;
      qf[0] = *reinterpret_cast<const bf16x8*>(qp);
      qf[1] = *reinterpret_cast<const bf16x8*>(qp + 32);
    }
    __syncthreads();
    f32x4 o[4];
#pragma unroll
    for (int ds = 0; ds < 4; ++ds) o[ds] = f32x4{0.f, 0.f, 0.f, 0.f};
    float lsum = 0.f;
    int npairs = 8, cq = -1;
    if (slot_own) { cq = (tq & 255); npairs = (((q0 & 255) + wid * 16 + 15) >> 5) + 1; }
    attn_wave<64, 256>(lds + K_OFF, lds + VT_OFF, qf, npairs, cq, c1, c2, o, lsum, fr, fq);
    lsum += __shfl_xor(lsum, 16);
    lsum += __shfl_xor(lsum, 32);
    if (valid) {
      const size_t pidx = (((size_t)(bh >> 3) * SEQ + tq) * 8 + (bh & 7)) * 4 + slot;
#pragma unroll
      for (int ds = 0; ds < 4; ++ds) {
        uint2 w; w.x = pack2(o[ds][0], o[ds][1]); w.y = pack2(o[ds][2], o[ds][3]);
        *reinterpret_cast<uint2*>(opart + pidx * 64 + ds * 16 + fq * 4) = w;
      }
      if (fq == 0) lpart[pidx] = lsum;
    }
  }
}

__device__ void phase_moba_combine(const MP& p0) {
  const MP p = kparams_load(); (void)p0;
  const int tid = opaque_tid();
  const u16* opart = (const u16*)p.out;
  const float* lpart = (const float*)(p.ws + WS_LPART);
  u16* attn = (u16*)(p.ws + WS_ATTN);
  for (size_t i = (size_t)blockIdx.x * NTHR + tid; i < (size_t)TTOK * 8 * 8; i += (size_t)gridDim.x * NTHR) {
    const size_t th = i >> 3;
    const int c = (int)(i & 7) * 8;
    const int t = (int)((th >> 3) % SEQ);
    const int qblk = t >> 8;
    const int nsel = qblk < 3 ? qblk : 3;
    const float4 l4 = *reinterpret_cast<const float4*>(lpart + th * 4);
    const float lv[4] = {l4.x, l4.y, l4.z, l4.w};
    float acc[8] = {0.f, 0.f, 0.f, 0.f, 0.f, 0.f, 0.f, 0.f};
    float l = 0.f;
#pragma unroll
    for (int s2 = 0; s2 < 4; ++s2) {
      const bool ok = (s2 == 3) || (s2 < nsel);
      if (ok) {
        float f[8];
        unpack8(*reinterpret_cast<const uint4*>(opart + (th * 4 + s2) * 64 + c), f);
#pragma unroll
        for (int j = 0; j < 8; ++j) acc[j] += f[j];
        l += lv[s2];
      }
    }
    const float il = 1.0f / l;
#pragma unroll
    for (int j = 0; j < 8; ++j) acc[j] *= il;
    *reinterpret_cast<uint4*>(attn + th * 64 + c) = pack8(acc);
  }
}


__device__ void phase_xattn(const MP& p0) {
  extern __shared__ __attribute__((aligned(16))) unsigned char lds_raw[];
  const MP p = kparams_load(); (void)p0;
  const int tid = opaque_tid();
  LAS unsigned char* lds = (LAS unsigned char*)lds_raw;
  constexpr int K_OFF = 0, VT_OFF = 128 * 272, MISC_OFF = 2 * 128 * 272;
  float* misc = reinterpret_cast<float*>(lds_raw + MISC_OFF);
  const u16* proj = (const u16*)(p.ws + WS_PROJ);
  const u16* kmn = (const u16*)(p.ws + WS_KMEMN);
  const u16* vmt = (const u16*)(p.ws + WS_VMT);
  const float* g_cq = p.in[18];
  u16* xattn = (u16*)(p.ws + WS_XATTN);
  const int wid = tid >> 6, lane = tid & 63, fr = lane & 15, fq = lane >> 4;
  if (tid < 64) {
    float mq = fmaxf(fabsf(g_cq[tid]), fabsf(g_cq[tid + 64])), mk = fmaxf(fabsf(p.in[19][tid]), fabsf(p.in[19][tid + 64]));
#pragma unroll
    for (int o = 32; o > 0; o >>= 1) { mq = fmaxf(mq, __shfl_xor(mq, o)); mk = fmaxf(mk, __shfl_xor(mk, o)); }
    if (tid == 0) misc[0] = 11.313708498984761f * mq * mk * 1.02f;
  }
  __syncthreads();
  const float c1 = 0.08838834764831845f * 1.4426950408889634f, c2 = misc[0] * 1.4426950408889634f;
  for (int item = blockIdx.x; item < 2 * 4 * 128; item += gridDim.x) {
    const int qt = item & 127, xh = (item >> 7) & 3, b = item >> 9;
    const size_t tok = (size_t)b * SEQ + qt * 128 + wid * 16 + fr;
    bf16x8 qf[4];
    {
      float qv[4][8];
      float ss = 0.f;
      const u16* qp = proj + tok * 5632 + 2048 + xh * 128 + fq * 8;
#pragma unroll
      for (int ks = 0; ks < 4; ++ks) {
        unpack8(*reinterpret_cast<const uint4*>(qp + ks * 32), qv[ks]);
#pragma unroll
        for (int j = 0; j < 8; ++j) ss += qv[ks][j] * qv[ks][j];
      }
      ss += __shfl_xor(ss, 16);
      ss += __shfl_xor(ss, 32);
      const float r = rsqrtf(ss * (1.0f / 128.0f) + 1e-6f);
#pragma unroll
      for (int ks = 0; ks < 4; ++ks) {
        union { bf16x8 v; unsigned int u[4]; } pk;
#pragma unroll
        for (int j = 0; j < 4; ++j)
          pk.u[j] = pack2(qv[ks][2 * j] * r * g_cq[ks * 32 + fq * 8 + 2 * j], qv[ks][2 * j + 1] * r * g_cq[ks * 32 + fq * 8 + 2 * j + 1]);
        qf[ks] = pk.v;
      }
    }
    f32x4 o[8];
#pragma unroll
    for (int ds = 0; ds < 8; ++ds) o[ds] = f32x4{0.f, 0.f, 0.f, 0.f};
    float lsum = 0.f;
#pragma unroll 1
    for (int hf = 0; hf < 2; ++hf) {
      __syncthreads();
      const u16* kb = kmn + (((size_t)b * 4 + xh) * 256 + hf * 128) * 128;
      const u16* vb = vmt + ((size_t)b * 4 + xh) * 128 * 256 + hf * 128;
#pragma unroll
      for (int i = 0; i < 4; ++i) {
        const int rrow = (tid >> 4) + 32 * i, ch = tid & 15;
        *(LAS u32x4*)(lds + K_OFF + rrow * 272 + ch * 16) = *reinterpret_cast<const u32x4*>(kb + (size_t)rrow * 128 + ch * 8);
        *(LAS u32x4*)(lds + VT_OFF + rrow * 272 + ch * 16) = *reinterpret_cast<const u32x4*>(vb + (size_t)rrow * 256 + ch * 8);
      }
      __syncthreads();
      attn_wave<128, 128>(lds + K_OFF, lds + VT_OFF, qf, 4, -1, c1, c2, o, lsum, fr, fq);
    }
    lsum += __shfl_xor(lsum, 16);
    lsum += __shfl_xor(lsum, 32);
    const float il = 1.0f / lsum;
    u16* op = xattn + tok * 512 + xh * 128 + fq * 4;
#pragma unroll
    for (int ds = 0; ds < 8; ++ds) {
      uint2 w; w.x = pack2(o[ds][0] * il, o[ds][1] * il); w.y = pack2(o[ds][2] * il, o[ds][3] * il);
      *reinterpret_cast<uint2*>(op + ds * 16) = w;
    }
  }
}

__device__ void phase_glu(const MP& p0) {
  const MP p = kparams_load(); (void)p0;
  for (int unit = blockIdx.x; unit < 128 * 8; unit += gridDim.x) {
    const int tid = opaque_tid();
    int pm, pn;
    unit_order(unit, 128, 8, pm, pn);
    acc_t acc;
    acc_zero(acc);
    OpLin A = op_plain(tid, (const u16*)(p.ws + WS_YGELU), (long)pm * 256, 512);
    OpLin B = op_plain(tid, (const u16*)(p.ws + WS_WT_GLU), (long)pn * 256, 512);
    gemm_unit(tid, acc, A, B, 8);
    const int te = opaque_tid(), wr = (te >> 8) & 1, wc = (te >> 6) & 3, fr = te & 15, fq = (te >> 4) & 3;
    const u16* proj = (const u16*)(p.ws + WS_PROJ);
    u16* merged = (u16*)(p.ws + WS_MERGED);
    const int c0 = pn * 128 + wc * 32 + fq * 8;
#pragma unroll
    for (int ai = 0; ai < 2; ++ai)
#pragma unroll
      for (int m = 0; m < 4; ++m) {
        const size_t row = (size_t)pm * 256 + ai * 128 + wr * 64 + m * 16 + fr;
        float g[8], o[8];
        unpack8(*reinterpret_cast<const uint4*>(proj + row * 5632 + 2560 + c0), g);
#pragma unroll
        for (int n = 0; n < 2; ++n)
#pragma unroll
          for (int j = 0; j < 4; ++j)
            o[n * 4 + j] = sigmoidf_(g[n * 4 + j]) * acc[ai][0][m][n][j] * sigmoidf_(acc[ai][1][m][n][j]);
        *reinterpret_cast<uint4*>(merged + row * 1024 + c0) = pack8(o);
      }
  }
}

__device__ void phase_moco(const MP& p0) {
  const MP p = kparams_load(); (void)p0;
  for (int unit = blockIdx.x; unit < 128 * 4; unit += gridDim.x) {
    int pm, pn;
    unit_order(unit, 128, 4, pm, pn);
#pragma unroll 1
    for (int pass = 0; pass < 2; ++pass) {
      const int tid = opaque_tid();
      acc_t acc;
      acc_zero(acc);
      OpLin A = op_plain(tid, (const u16*)(p.ws + (pass ? WS_XATTN : WS_ATTN)), (long)pm * 256, 512);
      OpLin B = op_plain(tid, (const u16*)(p.ws + (pass ? WS_WT_CO : WS_WT_MO)), (long)pn * 256, 512);
      gemm_unit(tid, acc, A, B, 8);
      const int te = opaque_tid(), wr = (te >> 8) & 1, wc = (te >> 6) & 3, fr = te & 15, fq = (te >> 4) & 3;
      const u16* proj = (const u16*)(p.ws + WS_PROJ);
      u16* merged = (u16*)(p.ws + WS_MERGED);
      const int goff = 2560 + 1024 + pass * 1024;
#pragma unroll
      for (int ai = 0; ai < 2; ++ai)
#pragma unroll
        for (int m = 0; m < 4; ++m) {
          const size_t row = (size_t)pm * 256 + ai * 128 + wr * 64 + m * 16 + fr;
#pragma unroll
          for (int bj = 0; bj < 2; ++bj) {
            const int col = pn * 256 + bj * 128 + wc * 32 + fq * 8;
            float g[8], o[8];
            unpack8(*reinterpret_cast<const uint4*>(proj + row * 5632 + goff + col), g);
            unpack8(*reinterpret_cast<const uint4*>(merged + row * 1024 + col), o);
#pragma unroll
            for (int n = 0; n < 2; ++n)
#pragma unroll
              for (int j = 0; j < 4; ++j) o[n * 4 + j] += sigmoidf_(g[n * 4 + j]) * acc[ai][bj][m][n][j];
            *reinterpret_cast<uint4*>(merged + row * 1024 + col) = pack8(o);
          }
        }
    }
  }
}

__device__ void phase_outproj(const MP& p0) {
  const MP p = kparams_load(); (void)p0;
  for (int unit = blockIdx.x; unit < 128 * 4; unit += gridDim.x) {
    const int tid = opaque_tid();
    int pm, pn;
    unit_order(unit, 128, 4, pm, pn);
    acc_t acc;
    acc_zero(acc);
    OpLin A = op_plain(tid, (const u16*)(p.ws + WS_MERGED), (long)pm * 256, 1024);
    OpLin B = op_plain(tid, (const u16*)(p.ws + WS_WT_OUT), (long)pn * 256, 1024);
    gemm_unit(tid, acc, A, B, 16);
    const int te = opaque_tid(), wr = (te >> 8) & 1, wc = (te >> 6) & 3, fr = te & 15, fq = (te >> 4) & 3;
    const float* x = p.in[0];
    float* out = p.out;
#pragma unroll
    for (int ai = 0; ai < 2; ++ai)
#pragma unroll
      for (int m = 0; m < 4; ++m) {
        const size_t row = (size_t)pm * 256 + ai * 128 + wr * 64 + m * 16 + fr;
#pragma unroll
        for (int bj = 0; bj < 2; ++bj)
#pragma unroll
          for (int n = 0; n < 2; ++n) {
            const int col = pn * 256 + bj * 128 + wc * 32 + fq * 8 + n * 4;
            float4 xv = *reinterpret_cast<const float4*>(x + row * 1024 + col);
            float4 o;
            o.x = xv.x + acc[ai][bj][m][n][0]; o.y = xv.y + acc[ai][bj][m][n][1];
            o.z = xv.z + acc[ai][bj][m][n][2]; o.w = xv.w + acc[ai][bj][m][n][3];
            *reinterpret_cast<float4*>(out + row * 1024 + col) = o;
          }
      }
  }
}

__device__ void phase_route(const MP& p0) {
  const MP p = kparams_load(); (void)p0;
  extern __shared__ __attribute__((aligned(16))) unsigned char lds_raw[];
  const float* x1 = p.out;
  const float* g_ffn = p.in[22];
  const float* b_router = p.in[24];
  const float* gw = reinterpret_cast<const float*>(p.ws + WS_GW);
  u16* h2 = reinterpret_cast<u16*>(p.ws + WS_H2);
  int* list = reinterpret_cast<int*>(p.ws + WS_LIST);
  float* topw = reinterpret_cast<float*>(p.ws + WS_TOPW);
  int* cnt = reinterpret_cast<int*>(p.ws + WS_CNT);
  const int tid = opaque_tid(), wid = tid >> 6, lane = tid & 63;
  float* lg = reinterpret_cast<float*>(lds_raw) + wid * (16 * 33);
  int* hist = reinterpret_cast<int*>(lds_raw + 8 * 16 * 33 * 4);
  int* gbase = hist + 32;
  const int i16 = lane & 15, kk = lane >> 4;
  for (int bt = blockIdx.x; bt < TTOK / 128; bt += gridDim.x) {
    const int tok0 = bt * 128 + wid * 16;
    if (tid < 32) hist[tid] = 0;
    __syncthreads();
    f32x4 acc0 = {0.f, 0.f, 0.f, 0.f}, acc1 = {0.f, 0.f, 0.f, 0.f};
    float ssq = 0.f;
    const float* xr = x1 + (size_t)(tok0 + i16) * 1024 + 4 * kk;
    for (int s = 0; s < 64; ++s) {
      float4 a = *reinterpret_cast<const float4*>(xr + 16 * s);
      ssq += a.x * a.x + a.y * a.y + a.z * a.z + a.w * a.w;
      const float* wb = gw + (size_t)(16 * s + 4 * kk) * 32 + i16;
      float av[4] = {a.x, a.y, a.z, a.w};
#pragma unroll
      for (int r = 0; r < 4; ++r) {
        float b0 = wb[r * 32], b1 = wb[r * 32 + 16];
        acc0 = __builtin_amdgcn_mfma_f32_16x16x4f32(av[r], b0, acc0, 0, 0, 0);
        acc1 = __builtin_amdgcn_mfma_f32_16x16x4f32(av[r], b1, acc1, 0, 0, 0);
      }
    }
    ssq += __shfl_xor(ssq, 16);
    ssq += __shfl_xor(ssq, 32);
    const float rstd = rsqrtf(ssq * (1.0f / 1024.0f) + 1e-6f);
#pragma unroll
    for (int r = 0; r < 4; ++r) {
      lg[(kk * 4 + r) * 33 + i16] = acc0[r];
      lg[(kk * 4 + r) * 33 + 16 + i16] = acc1[r];
    }
    asm volatile("s_waitcnt lgkmcnt(0)" ::: "memory");
    int sel_e[4] = {0, 0, 0, 0};
    float sel_w[4] = {0.f, 0.f, 0.f, 0.f};
    int lpos[4] = {0, 0, 0, 0};
    if (lane < 16) {
      float v[32];
#pragma unroll
      for (int e = 0; e < 32; ++e) v[e] = lg[lane * 33 + e] * rstd + b_router[e];
      unsigned used = 0u;
      float tv[4];
#pragma unroll
      for (int k = 0; k < 4; ++k) {
        float best = -INFINITY; int bi = 0;
#pragma unroll
        for (int e = 0; e < 32; ++e) {
          bool ok = !((used >> e) & 1u);
          if (ok && v[e] > best) { best = v[e]; bi = e; }
        }
        used |= (1u << bi);
        tv[k] = best; sel_e[k] = bi;
      }
      float e0 = 1.0f, e1 = expf(tv[1] - tv[0]), e2 = expf(tv[2] - tv[0]), e3 = expf(tv[3] - tv[0]);
      float inv = 1.0f / (e0 + e1 + e2 + e3);
      sel_w[0] = e0 * inv; sel_w[1] = e1 * inv; sel_w[2] = e2 * inv; sel_w[3] = e3 * inv;
#pragma unroll
      for (int k = 0; k < 4; ++k) lpos[k] = atomicAdd(&hist[sel_e[k]], 1);
    }
    for (int j = 0; j < 16; ++j) {
      float rs = __shfl(rstd, j);
      const float* xrow = x1 + (size_t)(tok0 + j) * 1024;
      u16* hrow = h2 + (size_t)(tok0 + j) * 1024;
#pragma unroll
      for (int q = 0; q < 4; ++q) {
        int c = q * 256 + lane * 4;
        float4 a = *reinterpret_cast<const float4*>(xrow + c);
        float4 g = *reinterpret_cast<const float4*>(g_ffn + c);
        uint2 o;
        o.x = pack2(a.x * rs * g.x, a.y * rs * g.y);
        o.y = pack2(a.z * rs * g.z, a.w * rs * g.w);
        *reinterpret_cast<uint2*>(hrow + c) = o;
      }
    }
    __syncthreads();
    if (tid < 32) gbase[tid] = hist[tid] ? atomicAdd(&cnt[tid], hist[tid]) : 0;
    __syncthreads();
    if (lane < 16) {
      int tok = tok0 + lane;
#pragma unroll
      for (int k = 0; k < 4; ++k) {
        int e = sel_e[k];
        list[(size_t)e * TTOK + gbase[e] + lpos[k]] = tok * 4 + k;
        topw[tok * 4 + k] = sel_w[k];
      }
    }
    __syncthreads();
  }
}

struct MoeMap { int tilebase[33]; int rowbase[33]; int cnt[32]; };
__device__ __forceinline__ MoeMap* moe_map_build(const MP& p) {
  extern __shared__ __attribute__((aligned(16))) unsigned char lds_raw[];
  MoeMap* mm = reinterpret_cast<MoeMap*>(lds_raw + LDS_MISC_OFF);
  const int* cnt = reinterpret_cast<const int*>(p.ws + WS_CNT);
  if (threadIdx.x == 0) {
    int tb = 0;
    for (int e = 0; e < 32; ++e) {
      int c = cnt[e];
      mm->cnt[e] = c; mm->tilebase[e] = tb; mm->rowbase[e] = tb * 256;
      tb += (c + 255) >> 8;
    }
    mm->tilebase[32] = tb; mm->rowbase[32] = tb * 256;
  }
  __syncthreads();
  return mm;
}

__device__ void phase_moe1(const MP& p0) {
  const MP p = kparams_load(); (void)p0;
  MoeMap* mm = moe_map_build(p);
  const u16* h2 = reinterpret_cast<const u16*>(p.ws + WS_H2);
  const u16* wt_gu = reinterpret_cast<const u16*>(p.ws + WS_WT_GU);
  u16* actb = reinterpret_cast<u16*>(p.ws + WS_ACT);
  const int* list = reinterpret_cast<const int*>(p.ws + WS_LIST);
  const float* b_gu = p.in[26];
  const int total = mm->tilebase[32] * 8;
  for (int tile = blockIdx.x; tile < total; tile += gridDim.x) {
    const int tid = opaque_tid();
    int rtg = tile >> 3, ct = tile & 7;
    int e = 0;
    while (mm->tilebase[e + 1] <= rtg) ++e;
    const int rt = rtg - mm->tilebase[e];
    const int cnt_e = mm->cnt[e];
    const int* le = list + (size_t)e * TTOK + rt * 256;
    const int nvalid = cnt_e - rt * 256;
    OpGat A;
    A.base = reinterpret_cast<const char*>(h2); A.kstep = 128;
#pragma unroll
    for (int i = 0; i < 2; ++i) {
      int R, C; stage_rc(tid * 16 + i * 8192, R, C);
#pragma unroll
      for (int h = 0; h < 2; ++h) {
        int r = h * 128 + R;
        int ent = le[(r < nvalid) ? r : 0];
        A.voff[h][i] = (unsigned)(((ent >> 2) * 1024 + C) * 2);
      }
    }
    OpLin B = op_plain(tid, wt_gu + (size_t)e * 2048 * 1024, ct * 256, 1024);
    acc_t acc;
    acc_zero(acc);
    gemm_unit(tid, acc, A, B, 16);
    const int te = opaque_tid(), wr = (te >> 8) & 1, wc = (te >> 6) & 3, fr = te & 15, fq = (te >> 4) & 3;
    const float* bg = b_gu + (size_t)e * 2048;
    u16* arow = actb + (size_t)(mm->rowbase[e] + rt * 256) * 1024;
    const int c0 = ct * 128 + wc * 32 + fq * 8;
    float bgate[8], bup[8];
#pragma unroll
    for (int q = 0; q < 8; ++q) { bgate[q] = bg[c0 + q]; bup[q] = bg[1024 + c0 + q]; }
#pragma unroll
    for (int ai = 0; ai < 2; ++ai)
#pragma unroll
      for (int m = 0; m < 4; ++m) {
        const int r = ai * 128 + wr * 64 + m * 16 + fr;
        float a8[8];
#pragma unroll
        for (int n = 0; n < 2; ++n)
#pragma unroll
          for (int j = 0; j < 4; ++j) {
            float ga = acc[ai][0][m][n][j] + bgate[n * 4 + j];
            float up = acc[ai][1][m][n][j] + bup[n * 4 + j];
            ga = fminf(ga, 7.0f);
            up = fminf(fmaxf(up, -7.0f), 7.0f);
            float sg = __builtin_amdgcn_rcpf(1.f + __expf(-1.702f * ga));
            a8[n * 4 + j] = ga * sg * (up + 1.0f);
          }
        if (r < nvalid) {
          uint4 o;
          o.x = pack2(a8[0], a8[1]); o.y = pack2(a8[2], a8[3]); o.z = pack2(a8[4], a8[5]); o.w = pack2(a8[6], a8[7]);
          *reinterpret_cast<uint4*>(arow + (size_t)r * 1024 + c0) = o;
        }
      }
  }
}

__device__ void phase_moe2(const MP& p0) {
  const MP p = kparams_load(); (void)p0;
  MoeMap* mm = moe_map_build(p);
  const u16* actb = reinterpret_cast<const u16*>(p.ws + WS_ACT);
  const u16* wt_down = reinterpret_cast<const u16*>(p.ws + WS_WT_DOWN);
  u16* yslot = reinterpret_cast<u16*>(p.ws + WS_YSLOT);
  const int* list = reinterpret_cast<const int*>(p.ws + WS_LIST);
  const float* topw = reinterpret_cast<const float*>(p.ws + WS_TOPW);
  const float* b_down = p.in[28];
  const int total = mm->tilebase[32] * 4;
  for (int tile = blockIdx.x; tile < total; tile += gridDim.x) {
    const int tid = opaque_tid();
    int rtg = tile >> 2, ct = tile & 3;
    int e = 0;
    while (mm->tilebase[e + 1] <= rtg) ++e;
    const int rt = rtg - mm->tilebase[e];
    const int nvalid = mm->cnt[e] - rt * 256;
    const int* le = list + (size_t)e * TTOK + rt * 256;
    OpLin A = op_plain(tid, actb, (long)mm->rowbase[e] + rt * 256, 1024);
    OpLin B = op_plain(tid, wt_down + (size_t)e * 1024 * 1024, ct * 256, 1024);
    acc_t acc;
    acc_zero(acc);
    gemm_unit(tid, acc, A, B, 16);
    const int te = opaque_tid(), wr = (te >> 8) & 1, wc = (te >> 6) & 3, fr = te & 15, fq = (te >> 4) & 3;
    const float* bd = b_down + (size_t)e * 1024;
#pragma unroll
    for (int ai = 0; ai < 2; ++ai)
#pragma unroll
      for (int m = 0; m < 4; ++m) {
        const int r = ai * 128 + wr * 64 + m * 16 + fr;
        if (r < nvalid) {
          const int ent = le[r];
          const float w = topw[ent];
          u16* yrow = yslot + (size_t)ent * 1024;
#pragma unroll
          for (int bj = 0; bj < 2; ++bj) {
            const int col = ct * 256 + bj * 128 + wc * 32 + fq * 8;
            float4 b0 = *reinterpret_cast<const float4*>(bd + col);
            float4 b1 = *reinterpret_cast<const float4*>(bd + col + 4);
            uint4 o;
            o.x = pack2(w * (acc[ai][bj][m][0][0] + b0.x), w * (acc[ai][bj][m][0][1] + b0.y));
            o.y = pack2(w * (acc[ai][bj][m][0][2] + b0.z), w * (acc[ai][bj][m][0][3] + b0.w));
            o.z = pack2(w * (acc[ai][bj][m][1][0] + b1.x), w * (acc[ai][bj][m][1][1] + b1.y));
            o.w = pack2(w * (acc[ai][bj][m][1][2] + b1.z), w * (acc[ai][bj][m][1][3] + b1.w));
            *reinterpret_cast<uint4*>(yrow + col) = o;
          }
        }
      }
  }
}

__device__ void phase_moe_combine(const MP& p0) {
  const MP p = kparams_load(); (void)p0;
  const int tid0 = opaque_tid();
  const u16* yslot = reinterpret_cast<const u16*>(p.ws + WS_YSLOT);
  float* out = p.out;
  const size_t nvec = (size_t)TTOK * 1024 / 8;
  for (size_t i = (size_t)blockIdx.x * NTHR + tid0; i < nvec; i += (size_t)gridDim.x * NTHR) {
    size_t tok = i >> 7;
    int c = (int)(i & 127) * 8;
    float4 a = *reinterpret_cast<const float4*>(out + tok * 1024 + c);
    float4 b = *reinterpret_cast<const float4*>(out + tok * 1024 + c + 4);
    float v[8] = {a.x, a.y, a.z, a.w, b.x, b.y, b.z, b.w};
#pragma unroll
    for (int k = 0; k < 4; ++k) {
      uint4 y = *reinterpret_cast<const uint4*>(yslot + (tok * 4 + k) * 1024 + c);
      unsigned int w[4] = {y.x, y.y, y.z, y.w};
#pragma unroll
      for (int q = 0; q < 4; ++q) {
        v[2 * q] += __uint_as_float(w[q] << 16);
        v[2 * q + 1] += __uint_as_float(w[q] & 0xffff0000u);
      }
    }
    *reinterpret_cast<float4*>(out + tok * 1024 + c) = make_float4(v[0], v[1], v[2], v[3]);
    *reinterpret_cast<float4*>(out + tok * 1024 + c + 4) = make_float4(v[4], v[5], v[6], v[7]);
  }
}

enum { PH_PREP = 0, PH_GEMM1, PH_S5S_KPREP, PH_SCAN_GATE, PH_S5Y_MOBA_XATTN, PH_MOBAC_GLU, PH_MOCO, PH_OUT, PH_ROUTE, PH_MOE1, PH_MOE2,
       PH_COMBINE, PH_COUNT };

#ifndef PHMASK
#define PHMASK 0xffffffffu
#endif
#define RUN_PHASE(ph, call)                                   \
  if ((PHMASK >> (ph)) & 1u) {                                \
    if (p.ph_lo <= (ph) && (ph) < p.ph_hi) {                  \
      if ((ph) > p.ph_lo) grid.sync();                        \
      call;                                                   \
    }                                                         \
  }
__global__ void __launch_bounds__(NTHR) mega(MP p) {
  cg::grid_group grid = cg::this_grid();
  RUN_PHASE(PH_PREP, { phase_prep_mix(p); __syncthreads(); phase_prep_moe(p); });
  RUN_PHASE(PH_GEMM1, phase_gemm1(p));
  RUN_PHASE(PH_S5S_KPREP, { phase_s5s(p); __syncthreads(); phase_kprep(p); });
  RUN_PHASE(PH_SCAN_GATE, { phase_s5scan(p); __syncthreads(); phase_gate(p); });
  RUN_PHASE(PH_S5Y_MOBA_XATTN, { phase_s5y(p); __syncthreads(); phase_moba(p); __syncthreads(); phase_xattn(p); });
  RUN_PHASE(PH_MOBAC_GLU, { phase_moba_combine(p); __syncthreads(); phase_glu(p); });
  RUN_PHASE(PH_MOCO, phase_moco(p));
  RUN_PHASE(PH_OUT, phase_outproj(p));
  RUN_PHASE(PH_ROUTE, phase_route(p));
  RUN_PHASE(PH_MOE1, phase_moe1(p));
  RUN_PHASE(PH_MOE2, phase_moe2(p));
  RUN_PHASE(PH_COMBINE, phase_moe_combine(p));
}

extern "C" void kernel_launch(void* const* d_in, const int* in_sizes, int n_in, void* d_out, int out_size, void* d_ws,
                              size_t ws_size, hipStream_t stream) {
  (void)in_sizes; (void)out_size;
  static int grid_blocks = 0;
  if (!grid_blocks) {
    int dev = 0, cus = 0, per_cu = 0;
    (void)hipGetDevice(&dev);
    (void)hipDeviceGetAttribute(&cus, hipDeviceAttributeMultiprocessorCount, dev);
    (void)hipFuncSetAttribute((const void*)mega, hipFuncAttributeMaxDynamicSharedMemorySize, LDS_TOTAL);
    (void)hipOccupancyMaxActiveBlocksPerMultiprocessor(&per_cu, (const void*)mega, NTHR, LDS_TOTAL);
    if (per_cu < 1) { fprintf(stderr, "kernel_launch: occupancy query reports %d blocks/CU\n", per_cu); per_cu = 1; }
    grid_blocks = cus;
  }
  if (n_in != 29 || ws_size < WS_END_A) { fprintf(stderr, "kernel_launch: bad inputs (n_in %d) or workspace too small: %zu < %zu\n", n_in, ws_size, (size_t)WS_END_A); return; }
  MP mp{};
  for (int i = 0; i < 29; ++i) mp.in[i] = (const float*)d_in[i];
  mp.out = (float*)d_out;
  mp.ws = (unsigned char*)d_ws;
  mp.ph_lo = 0; mp.ph_hi = PH_COUNT;
  void* args[] = {&mp};
  hipError_t e = hipLaunchCooperativeKernel((const void*)mega, dim3(grid_blocks), dim3(NTHR), args, LDS_TOTAL, stream);
  if (e != hipSuccess) fprintf(stderr, "cooperative launch failed: %s (grid %d)\n", hipGetErrorString(e), grid_blocks);
}
```

```cpp
#include <hip/hip_runtime.h>
#include <hip/hip_cooperative_groups.h>
#include <cstdio>
#include <math.h>
#include <stdint.h>
namespace cg = cooperative_groups;

#define D_MODEL 1024
#define BATCH 2
#define SEQ 16384
#define TTOK (BATCH * SEQ)
#define IN_COLS 5632
#define NEXP 32

__device__ __forceinline__ void sincos_acc(float ang, float& s, float& c) {
  double a = (double)ang;
  double kf = rint(a * 0.6366197723675814);
  double r = fma(-kf, 1.5707963267948966, a);
  r = fma(-kf, 6.123233995736766e-17, r);
  int q = ((int)kf) & 3;
  float x = (float)r;
  float x2 = x * x;
  float sp = x + x * x2 * (-1.6666654611e-1f + x2 * (8.3321608736e-3f + x2 * (-1.9515295891e-4f)));
  float cp = 1.0f - 0.5f * x2 + x2 * x2 * (4.166664568298827e-2f + x2 * (-1.388731625493765e-3f + x2 * 2.443315711809948e-5f));
  float ss = (q & 1) ? cp : sp;
  float cc = (q & 1) ? sp : cp;
  if (q == 1 || q == 2) cc = -cc;
  if (q >= 2) ss = -ss;
  s = ss; c = cc;
}


#define NTHR 512
typedef __attribute__((ext_vector_type(8))) short bf16x8;
typedef __attribute__((ext_vector_type(4))) float f32x4;
typedef unsigned short u16;
typedef __attribute__((ext_vector_type(4))) unsigned int u32x4;
typedef __attribute__((ext_vector_type(2))) unsigned int u32x2;

typedef __bf16 bf16v2 __attribute__((ext_vector_type(2)));
typedef float f32v2 __attribute__((ext_vector_type(2)));
typedef _Float16 h16x2 __attribute__((ext_vector_type(2)));
typedef short i16x2 __attribute__((ext_vector_type(2)));
__device__ __forceinline__ u16 f2bf(float f) { return __builtin_bit_cast(u16, (__bf16)f); }
__device__ __forceinline__ float bf2f(u16 h) { return __uint_as_float(((unsigned int)h) << 16); }
__device__ __forceinline__ unsigned int pack2(float a, float b) { f32v2 v = {a, b}; return __builtin_bit_cast(unsigned int, __builtin_convertvector(v, bf16v2)); }

typedef int i32x8 __attribute__((ext_vector_type(8)));
typedef int i32x4 __attribute__((ext_vector_type(4)));
__device__ __forceinline__ unsigned int pack4_fp8(float a, float b, float c, float d) {
  a = fminf(fmaxf(a, -448.f), 448.f); b = fminf(fmaxf(b, -448.f), 448.f);
  c = fminf(fmaxf(c, -448.f), 448.f); d = fminf(fmaxf(d, -448.f), 448.f);
  int w = 0;
  w = __builtin_amdgcn_cvt_pk_fp8_f32(a, b, w, false);
  w = __builtin_amdgcn_cvt_pk_fp8_f32(c, d, w, true);
  return (unsigned int)w;
}
__device__ __forceinline__ unsigned int pack4_fp8_ns(float a, float b, float c, float d) {
  int w = 0;
  w = __builtin_amdgcn_cvt_pk_fp8_f32(a, b, w, false);
  w = __builtin_amdgcn_cvt_pk_fp8_f32(c, d, w, true);
  return (unsigned int)w;
}
#define MOE_WSCALE 32.0f
#define ATT_SCALE 16.0f

#define TK_ROWS (TTOK * 4)
constexpr size_t al256(size_t x) { return (x + 255) & ~(size_t)255; }
constexpr size_t WS_WT_IN = 0;
constexpr size_t WS_WT_GLU = WS_WT_IN + (size_t)5632 * 1024 * 2;
constexpr size_t WS_WT_MO = WS_WT_GLU + (size_t)2048 * 512 * 2;
constexpr size_t WS_WT_CO = WS_WT_MO + (size_t)1024 * 512 * 2;
constexpr size_t WS_WT_OUT = WS_WT_CO + (size_t)1024 * 512 * 2;
constexpr size_t WS_WT_KV = WS_WT_OUT + (size_t)1024 * 1024 * 2;
constexpr size_t WS_WT_GU = WS_WT_KV + (size_t)1024 * 1024 * 2;
constexpr size_t WS_WT_DOWN = WS_WT_GU + (size_t)32 * 2048 * 1024 * 2;
constexpr size_t WS_GW = WS_WT_DOWN + (size_t)32 * 1024 * 1024 * 2;
constexpr size_t WS_CNT = WS_GW + (size_t)1024 * 32 * 4;
constexpr size_t WS_BAR = al256(WS_CNT + 8192);
constexpr size_t WS_KT = al256(WS_BAR + 16384);
constexpr size_t WS_FT = WS_KT + (size_t)32 * 127 * 256 * 2;
constexpr size_t WS_ET = WS_FT + (size_t)32 * 128 * 1024 * 2;
constexpr size_t WS_A64 = WS_ET + (size_t)32 * 1024 * 128 * 2;
constexpr size_t WS_ROPE = al256(WS_A64 + (size_t)32 * 64 * 2 * 4);
constexpr size_t WS_M0 = al256(WS_ROPE + (size_t)SEQ * 64 * 4);
constexpr size_t WS_PROJ = WS_M0;
constexpr size_t WS_H = WS_PROJ + (size_t)TTOK * 5632 * 2;
constexpr size_t WS_VT = WS_H + (size_t)TTOK * 1024 * 2;
constexpr size_t WS_YGELU = WS_VT + (size_t)TTOK * 512 * 2;
constexpr size_t WS_ATTN = WS_YGELU + (size_t)TTOK * 512 * 2;
constexpr size_t WS_XATTN = WS_ATTN + (size_t)TTOK * 512 * 2;
constexpr size_t WS_H16 = WS_ATTN;
constexpr size_t WS_WT_IN16 = WS_WT_IN + (size_t)6 * 1024 * 1024;
constexpr size_t WS_MERGED = WS_XATTN + (size_t)TTOK * 512 * 2;
constexpr size_t WS_MEMN = WS_MERGED + (size_t)TTOK * 1024 * 2;
constexpr size_t WS_KRAW = WS_MEMN + (size_t)512 * 1024 * 2;
constexpr size_t WS_VMT = WS_KRAW + (size_t)512 * 512 * 4;
constexpr size_t WS_S5S = WS_VMT + (size_t)512 * 512 * 2;
constexpr size_t WS_CARRY = WS_S5S + (size_t)2 * 512 * 32 * 128 * 4;
constexpr size_t WS_QN = WS_CARRY + (size_t)512 * 32 * 128 * 2;
constexpr size_t WS_KN = WS_QN + (size_t)TTOK * 512 * 2;
constexpr size_t WS_KMEAN = WS_KN + (size_t)TTOK * 512 * 2;
constexpr size_t WS_MLIST = WS_KMEAN + (size_t)16 * 64 * 64 * 4;
constexpr size_t WS_LPART = WS_MLIST + (size_t)16 * 516096 * 4;
constexpr size_t WS_KMEMN = WS_LPART + (size_t)TTOK * 8 * 4 * 4;
constexpr size_t WS_M_END = al256(WS_KMEMN + (size_t)512 * 512 * 2);
#define WS_MCNT (WS_CNT + 256)
#define WS_QCTR (WS_CNT + 256 + 4096)
constexpr size_t WS_H2 = WS_M0;
constexpr size_t WS_ACT = WS_H2 + (size_t)TTOK * 1024 * 2;
constexpr size_t WS_YSLOT = WS_ACT + (size_t)(TK_ROWS + 8192) * 1024 * 2;
constexpr size_t WS_LIST = WS_YSLOT + (size_t)(TK_ROWS + 8192) * 1024 * 2;
constexpr size_t WS_TOPW = WS_LIST + (size_t)32 * TTOK * 4;
constexpr size_t WS_TOPP = WS_TOPW + (size_t)TK_ROWS * 4;
constexpr size_t WS_E_END = al256(WS_TOPP + (size_t)TK_ROWS * 4);
constexpr size_t WS_END_A = (WS_M_END > WS_E_END ? WS_M_END : WS_E_END);

struct MP {
  const float* in[29];
  float* out;
  unsigned char* ws;
  int ph_lo, ph_hi;
};

#define LDS_GEMM_BYTES 131072
#define LDS_MISC_OFF 159744
#define LDS_TOTAL 163840

__device__ __forceinline__ int lds_byte(int r, int c) {
  int st = (r >> 4) * 2 + (c >> 5), rr = r & 15, cc = c & 31, ob = rr * 64 + cc * 2;
  return st * 1024 + (ob ^ (((ob >> 9) & 1) << 5));
}
__device__ __forceinline__ void stage_rc(int b, int& R, int& C) {
  int st = b / 1024, sb = b % 1024, swz = sb ^ (((sb >> 9) & 1) << 5);
  R = (st >> 1) * 16 + swz / 64;
  C = (st & 1) * 32 + (swz % 64) / 2;
}

#define WAIT_V(n) asm volatile("s_waitcnt vmcnt(" #n ")" ::: "memory")
#define WAIT_VN(expr) asm volatile("s_waitcnt vmcnt(%0)" ::"n"(expr) : "memory")
#define WAIT_L(n) asm volatile("s_waitcnt lgkmcnt(" #n ")" ::: "memory")
#define BAR() do { asm volatile("" ::: "memory"); __builtin_amdgcn_s_barrier(); asm volatile("" ::: "memory"); } while (0)

typedef f32x4 acc_t[2][2][4][2];
template <class T> __device__ __forceinline__ T* opaque_ptr(T* q) { asm volatile("" : "+s"(q)); return q; }
__device__ __forceinline__ int opaque_tid() { int t = threadIdx.x; asm volatile("" : "+v"(t)); return t; }

#define LAS __attribute__((address_space(3)))
#define CAS __attribute__((address_space(4)))
__device__ __forceinline__ const CAS MP* kparams() {
  auto kp = __builtin_amdgcn_kernarg_segment_ptr();
  asm volatile("" : "+s"(kp));
  return (const CAS MP*)kp;
}
__device__ __forceinline__ MP kparams_load() {
  MP r{};
#if defined(__HIP_DEVICE_COMPILE__)
  const CAS MP* k = kparams();
#pragma unroll
  for (int i = 0; i < 29; ++i) r.in[i] = k->in[i];
  r.out = k->out; r.ws = k->ws; r.ph_lo = k->ph_lo; r.ph_hi = k->ph_hi;
#endif
  return r;
}

__device__ __forceinline__ int perm32(int rho) { const int n = rho >> 4, i = rho & 15; return 8 * (i >> 2) + 4 * n + (i & 3); }

struct OpLin {
  const char* base; unsigned voff[2]; long hstep; long kstep;
  __device__ __forceinline__ const char* ptr(int h, int i, int kt) const { return base + h * hstep + kt * kstep + voff[i]; }
};
struct OpGat {
  const char* base; unsigned voff[2][2]; long kstep;
  __device__ __forceinline__ const char* ptr(int h, int i, int kt) const { return base + kt * kstep + voff[h][i]; }
};
template <bool FP8> struct Frag;
template <> struct Frag<false> { bf16x8 k[2]; };
template <> struct Frag<true> { i32x8 v; };
template <bool FP8>
__device__ __forceinline__ void frag_load(Frag<FP8>& f, const LAS unsigned char* p) {
  const bf16x8 lo = *(const LAS bf16x8*)(p), hi = *(const LAS bf16x8*)(p + 1024);
  if constexpr (FP8) f.v = __builtin_shufflevector(__builtin_bit_cast(i32x4, lo), __builtin_bit_cast(i32x4, hi), 0, 1, 2, 3, 4, 5, 6, 7);
  else { f.k[0] = lo; f.k[1] = hi; }
}
template <bool FP8>
__device__ __forceinline__ f32x4 frag_mma(const Frag<FP8>& b, const Frag<FP8>& a, f32x4 c) {
  if constexpr (FP8) return __builtin_amdgcn_mfma_scale_f32_16x16x128_f8f6f4(b.v, a.v, c, 0, 0, 0, 0x7f7f7f7f, 0, 0x7f7f7f7f);
  else {
    c = __builtin_amdgcn_mfma_f32_16x16x32_bf16(b.k[0], a.k[0], c, 0, 0, 0);
    return __builtin_amdgcn_mfma_f32_16x16x32_bf16(b.k[1], a.k[1], c, 0, 0, 0);
  }
}
struct OpLin2 {
  OpLin s0, s1; int nt0;
  __device__ __forceinline__ const char* ptr(int h, int i, int kt) const { return kt < nt0 ? s0.ptr(h, i, kt) : s1.ptr(h, i, kt - nt0); }
};
__device__ __forceinline__ OpLin op_plain(int tid, const u16* mat, long row0, long ld, bool perm = false) {
  OpLin o;
  o.base = reinterpret_cast<const char*>(mat + row0 * ld);
#pragma unroll
  for (int i = 0; i < 2; ++i) {
    int R, C; stage_rc(tid * 16 + i * 8192, R, C);
    if (perm) R = (R & ~31) + perm32(R & 31);
    o.voff[i] = (unsigned)((R * ld + C) * 2);
  }
  o.hstep = 128 * ld * 2; o.kstep = 128;
  return o;
}

template <bool FP8, class OA, class OB>
__device__ __forceinline__ void gemm_unit(int tid, acc_t& acc, const OA& A, const OB& B, int nt) {
  extern __shared__ __attribute__((aligned(16))) unsigned char lds_raw[];
  LAS unsigned char* lds = (LAS unsigned char*)lds_raw;
  const int wid = __builtin_amdgcn_readfirstlane(tid >> 6), lane = tid & 63, wr = wid >> 2, wc = wid & 3,
            fr = lane & 15, fq = lane >> 4;
  const unsigned ldsw = (unsigned)wid * 1024u;
  const int aoff = lds_byte(wr * 64 + fr, fq * 8), boff = lds_byte(wc * 32 + fr, fq * 8);
#define HTB 16384
#define G_SA(b, h) (((b) * 2 + (h)) * HTB)
#define G_SB(b, h) ((4 + (b) * 2 + (h)) * HTB)
#define G_STAGE(bufoff, OP, h, kt)                                                                                  \
  do {                                                                                                              \
    _Pragma("unroll") for (int _i = 0; _i < 2; ++_i) __builtin_amdgcn_global_load_lds(                              \
        (const unsigned*)(OP).ptr((h), _i, (kt)), (LAS unsigned*)(lds + (bufoff) + ldsw + _i * 8192), 16, 0, 0);    \
  } while (0)
#define G_LDA(dst, b, h) do { _Pragma("unroll") for (int m = 0; m < 4; ++m) frag_load<FP8>(dst[m], lds + G_SA(b, h) + aoff + m * 2048); } while (0)
#define G_LDB(dst, b, h) do { _Pragma("unroll") for (int n = 0; n < 2; ++n) frag_load<FP8>(dst[n], lds + G_SB(b, h) + boff + n * 2048); } while (0)
#define G_MM(ai, bj, At, Bt) do { __builtin_amdgcn_s_setprio(1); _Pragma("unroll") for (int m = 0; m < 4; ++m) _Pragma("unroll") for (int n = 0; n < 2; ++n) acc[ai][bj][m][n] = frag_mma<FP8>(Bt[n], At[m], acc[ai][bj][m][n]); __builtin_amdgcn_s_setprio(0); } while (0)
#define G_BAR __builtin_amdgcn_s_barrier()
#define G_SCHED __builtin_amdgcn_sched_barrier(0)
  Frag<FP8> At[4], B0[2], B1[2];
  G_STAGE(G_SB(0, 0), B, 0, 0); G_STAGE(G_SA(0, 0), A, 0, 0); G_STAGE(G_SB(0, 1), B, 1, 0); G_STAGE(G_SA(0, 1), A, 1, 0);
  if (wr == 1) G_BAR;
  WAIT_V(4); G_BAR;
  G_STAGE(G_SB(1, 0), B, 0, 1); G_STAGE(G_SA(1, 0), A, 0, 1); G_STAGE(G_SB(1, 1), B, 1, 1);
  WAIT_V(6); G_BAR;
  for (int t = 0; t < nt; t += 2) {
    const bool last = (t == nt - 2);
    const int k1 = t + 1, k2 = last ? 0 : t + 2, k3 = last ? 1 : t + 3;
    G_LDB(B0, 0, 0); G_SCHED; G_LDA(At, 0, 0); G_STAGE(G_SA(1, 1), A, 1, k1);
    WAIT_L(8); G_BAR; WAIT_L(0); G_MM(0, 0, At, B0); G_BAR; G_SCHED;
    G_LDB(B1, 0, 1); G_STAGE(G_SB(0, 0), B, 0, k2);
    G_BAR; WAIT_L(0); G_MM(0, 1, At, B1); G_BAR;
    G_LDA(At, 0, 1); G_STAGE(G_SA(0, 0), A, 0, k2);
    G_BAR; WAIT_L(0); G_MM(1, 0, At, B0); G_BAR; G_SCHED;
    G_STAGE(G_SB(0, 1), B, 1, k2);
    WAIT_V(6); G_BAR; G_MM(1, 1, At, B1); G_BAR;
    G_LDB(B0, 1, 0); G_SCHED; G_LDA(At, 1, 0); G_STAGE(G_SA(0, 1), A, 1, k2);
    WAIT_L(8); G_BAR; WAIT_L(0); G_MM(0, 0, At, B0); G_BAR; G_SCHED;
    G_LDB(B1, 1, 1); G_STAGE(G_SB(1, 0), B, 0, k3);
    G_BAR; WAIT_L(0); G_MM(0, 1, At, B1); G_BAR;
    G_LDA(At, 1, 1); G_STAGE(G_SA(1, 0), A, 0, k3);
    G_BAR; WAIT_L(0); G_MM(1, 0, At, B0); G_BAR; G_SCHED;
    G_STAGE(G_SB(1, 1), B, 1, k3);
    WAIT_V(6); G_BAR; G_MM(1, 1, At, B1); G_BAR;
  }
  WAIT_V(0);
  if (wr == 0) G_BAR;
  G_BAR;
#undef G_SA
#undef G_SB
#undef G_STAGE
#undef G_LDA
#undef G_LDB
#undef G_MM
#undef G_BAR
#undef G_SCHED
}

__device__ __forceinline__ void acc_zero(acc_t& acc) {
#pragma unroll
  for (int a = 0; a < 2; ++a)
#pragma unroll
    for (int b = 0; b < 2; ++b)
#pragma unroll
      for (int m = 0; m < 4; ++m)
#pragma unroll
        for (int n = 0; n < 2; ++n) acc[a][b][m][n] = f32x4{0.f, 0.f, 0.f, 0.f};
}

template <class P>
__device__ __forceinline__ void gemm_stream(const P& pol) {
  extern __shared__ __attribute__((aligned(16))) unsigned char lds_raw[];
  LAS unsigned char* lds = (LAS unsigned char*)lds_raw;
  const int tid = opaque_tid();
  const int wid = __builtin_amdgcn_readfirstlane(tid >> 6), lane = tid & 63, wr = wid >> 2, wc = wid & 3, fr = lane & 15, fq = lane >> 4;
  const unsigned ldsw = (unsigned)wid * 1024u;
  const int aoff = lds_byte(wr * 64 + fr, fq * 8), boff = lds_byte(wc * 32 + fr, fq * 8);
  int nt = pol.nt();
  asm volatile("" : "+s"(nt));
#define HTB 16384
#define G_SA(b, h) (((b) * 2 + (h)) * HTB)
#define G_SB(b, h) ((4 + (b) * 2 + (h)) * HTB)
#define G_STAGE(bufoff, OP, h, kt)                                                                                  \
  do {                                                                                                              \
    _Pragma("unroll") for (int _i = 0; _i < 2; ++_i) __builtin_amdgcn_global_load_lds(                              \
        (const unsigned*)(OP).ptr((h), _i, (kt)), (LAS unsigned*)(lds + (bufoff) + ldsw + _i * 8192), 16, 0, 0);    \
  } while (0)
#define G_STAGE2(bufoff, OPC, OPN, h, kt)                                                                          \
  do {                                                                                                              \
    _Pragma("unroll") for (int _i = 0; _i < 2; ++_i) {                                                              \
      const char* _pc = (OPC).ptr((h), _i, (kt));                                                                   \
      const char* _pn = (OPN).ptr((h), _i, (kt));                                                                   \
      __builtin_amdgcn_global_load_lds((const unsigned*)(last ? _pn : _pc),                                         \
                                       (LAS unsigned*)(lds + (bufoff) + ldsw + _i * 8192), 16, 0, 0);               \
    }                                                                                                               \
  } while (0)
#define G_STAGE2(bufoff, OPC, OPN, h, kt)                                                                          \
  do {                                                                                                              \
    _Pragma("unroll") for (int _i = 0; _i < 2; ++_i) {                                                              \
      const char* _pc = (OPC).ptr((h), _i, (kt));                                                                   \
      const char* _pn = (OPN).ptr((h), _i, (kt));                                                                   \
      __builtin_amdgcn_global_load_lds((const unsigned*)(last ? _pn : _pc),                                         \
                                       (LAS unsigned*)(lds + (bufoff) + ldsw + _i * 8192), 16, 0, 0);               \
    }                                                                                                               \
  } while (0)
#define G_LDA(dst, b, h) do { _Pragma("unroll") for (int m = 0; m < 4; ++m) frag_load<P::FP8>(dst[m], lds + G_SA(b, h) + aoff + m * 2048); } while (0)
#define G_LDB(dst, b, h) do { _Pragma("unroll") for (int n = 0; n < 2; ++n) frag_load<P::FP8>(dst[n], lds + G_SB(b, h) + boff + n * 2048); } while (0)
#define G_MM(ai, bj, At, Bt) do { __builtin_amdgcn_s_setprio(1); _Pragma("unroll") for (int m = 0; m < 4; ++m) _Pragma("unroll") for (int n = 0; n < 2; ++n) acc[ai][bj][m][n] = frag_mma<P::FP8>(Bt[n], At[m], acc[ai][bj][m][n]); __builtin_amdgcn_s_setprio(0); } while (0)
#define G_BAR __builtin_amdgcn_s_barrier()
#define G_SCHED __builtin_amdgcn_sched_barrier(0)
#define G_PIN do { if constexpr (P::FP8 && !P::HALFN) __builtin_amdgcn_sched_barrier(0); } while (0)
  typename P::Unit cur, nxt, nxt2;
  if (!pol.unit(0, cur)) return;
  bool has1 = pol.unit(1, nxt);
  typename P::OA A, An;
  typename P::OB B, Bn;
  pol.ops(cur, A, B);
  acc_t acc;
  acc_zero(acc);
  Frag<P::FP8> At[4], B0[2], B1[2];
  G_STAGE(G_SB(0, 0), B, 0, 0); G_STAGE(G_SA(0, 0), A, 0, 0); if constexpr (!P::HALFN) G_STAGE(G_SB(0, 1), B, 1, 0); G_STAGE(G_SA(0, 1), A, 1, 0);
  if (wr == 1) G_BAR;
  WAIT_V(0);
  G_BAR;
  G_STAGE(G_SB(1, 0), B, 0, 1); G_STAGE(G_SA(1, 0), A, 0, 1); if constexpr (!P::HALFN) G_STAGE(G_SB(1, 1), B, 1, 1);
  if constexpr (P::HALFN) WAIT_V(4); else WAIT_V(6);
  G_BAR;
  if constexpr (P::EPI_VM > 0) G_STAGE(G_SA(1, 1), A, 1, 1);
  for (int ui = 0;; ++ui) {
    const bool has_next = has1, seam = (ui > 0);
    if (has_next) pol.ops(nxt, An, Bn); else { An = A; Bn = B; }
    const bool has2 = has_next ? pol.unit(ui + 2, nxt2) : false;
    for (int t = 0; t < nt; t += 2) {
      const bool last = (t == nt - 2);
      const int k1 = t + 1, k2 = last ? 0 : t + 2, k3 = last ? 1 : t + 3;
      G_LDB(B0, 0, 0); G_SCHED; G_LDA(At, 0, 0); if constexpr (P::EPI_VM == 0) G_STAGE(G_SA(1, 1), A, 1, k1);
      WAIT_L(8); G_BAR; WAIT_L(0); G_PIN; G_MM(0, 0, At, B0); G_PIN; G_BAR; G_SCHED;
      if constexpr (!P::HALFN) G_LDB(B1, 0, 1);
      G_STAGE2(G_SB(0, 0), B, Bn, 0, k2);
      G_BAR; WAIT_L(0); if constexpr (!P::HALFN) G_PIN; G_MM(0, 1, At, B1); G_PIN;
      G_BAR;
      G_LDA(At, 0, 1); G_STAGE2(G_SA(0, 0), A, An, 0, k2);
      G_BAR; WAIT_L(0); G_PIN; G_MM(1, 0, At, B0); G_PIN; G_BAR; G_SCHED;
      if constexpr (!P::HALFN) { G_STAGE2(G_SB(0, 1), B, Bn, 1, k2); if (P::EPI_VM > 0 && seam && t == 0) WAIT_VN(6 + P::EPI_VM); else WAIT_V(6); }
      else { if (P::EPI_VM > 0 && seam && t == 0) WAIT_VN(4 + P::EPI_VM); else WAIT_V(4); }
      G_BAR; if constexpr (!P::HALFN) G_PIN; G_MM(1, 1, At, B1); G_PIN;
      G_BAR;
      G_LDB(B0, 1, 0); G_SCHED; G_LDA(At, 1, 0); G_STAGE2(G_SA(0, 1), A, An, 1, k2);
      WAIT_L(8); G_BAR; WAIT_L(0); G_PIN; G_MM(0, 0, At, B0); G_PIN; G_BAR; G_SCHED;
      if constexpr (!P::HALFN) G_LDB(B1, 1, 1);
      G_STAGE2(G_SB(1, 0), B, Bn, 0, k3);
      G_BAR; WAIT_L(0); if constexpr (!P::HALFN) G_PIN; G_MM(0, 1, At, B1); G_PIN;
      G_BAR;
      G_LDA(At, 1, 1); G_STAGE2(G_SA(1, 0), A, An, 0, k3);
      G_BAR; WAIT_L(0); G_PIN; G_MM(1, 0, At, B0); G_PIN; G_BAR; G_SCHED;
      if constexpr (!P::HALFN) { G_STAGE2(G_SB(1, 1), B, Bn, 1, k3); WAIT_V(6); } else { WAIT_V(4); }
      G_BAR; if constexpr (!P::HALFN) G_PIN; G_MM(1, 1, At, B1); G_PIN;
      if constexpr (P::EPI_VM > 0) G_STAGE2(G_SA(1, 1), A, An, 1, k3);
      G_BAR;
    }
    pol.epilogue(acc, cur);
    if (!has_next) break;
    acc_zero(acc);
    cur = nxt; nxt = nxt2; has1 = has2; A = An; B = Bn;
  }
  WAIT_V(0);
  if (wr == 0) G_BAR;
  G_BAR;
#undef G_SA
#undef G_SB
#undef G_STAGE
#undef G_STAGE2
#undef G_STAGE2
#undef G_LDA
#undef G_LDB
#undef G_MM
#undef G_BAR
#undef G_SCHED
#undef G_PIN
#undef HTB
}


__device__ __forceinline__ void unit_order(int Lin, int nM, int nN, int& pm, int& pn) {
  const int nwg = nM * nN;
  int wgid = Lin;
  { const int q = nwg / 8, r = nwg % 8, xcd = wgid % 8, off = wgid / 8; wgid = (xcd < r ? xcd * (q + 1) : r * (q + 1) + (xcd - r) * q) + off; }
  const int nig = 8 * nN, gid = wgid / nig, fm = gid * 8, gsz = (nM - fm) < 8 ? (nM - fm) : 8;
  pm = fm + ((wgid % nig) % gsz);
  pn = (wgid % nig) / gsz;
}
__device__ __forceinline__ float sigmoidf_(float x) { return __builtin_amdgcn_rcpf(1.f + __expf(-x)); }
__device__ __forceinline__ void unpack8(uint4 v, float (&f)[8]) {
  f[0] = __uint_as_float(v.x << 16); f[1] = __uint_as_float(v.x & 0xffff0000u);
  f[2] = __uint_as_float(v.y << 16); f[3] = __uint_as_float(v.y & 0xffff0000u);
  f[4] = __uint_as_float(v.z << 16); f[5] = __uint_as_float(v.z & 0xffff0000u);
  f[6] = __uint_as_float(v.w << 16); f[7] = __uint_as_float(v.w & 0xffff0000u);
}
__device__ __forceinline__ void unpack8_fp8(uint2 v, float (&f)[8]) {
  const f32v2 f0 = __builtin_amdgcn_cvt_pk_f32_fp8((int)v.x, false), f1 = __builtin_amdgcn_cvt_pk_f32_fp8((int)v.x, true);
  const f32v2 f2 = __builtin_amdgcn_cvt_pk_f32_fp8((int)v.y, false), f3 = __builtin_amdgcn_cvt_pk_f32_fp8((int)v.y, true);
  f[0] = f0[0]; f[1] = f0[1]; f[2] = f1[0]; f[3] = f1[1]; f[4] = f2[0]; f[5] = f2[1]; f[6] = f3[0]; f[7] = f3[1];
}
#define GATE8_OFF 5120
__device__ __forceinline__ uint4 pack8(const float (&f)[8]) {
  uint4 o; o.x = pack2(f[0], f[1]); o.y = pack2(f[2], f[3]); o.z = pack2(f[4], f[5]); o.w = pack2(f[6], f[7]); return o;
}
enum { MAP_PERM = 0, MAP_GLU = 1, MAP_GLU128 = 2 };
__device__ __forceinline__ int map_col(int np, int mode) {
  if (mode == MAP_PERM) return (np & ~31) + perm32(np & 31);
  if (mode == MAP_GLU128) { const int tile = np >> 7, sl = np & 127; return ((sl >> 4) & 1 ? 1024 : 0) + tile * 64 + (sl >> 5) * 16 + (sl & 15); }
  int tile = np >> 8, s = np & 255, bj = s >> 7, rem = s & 127;
  return (bj ? 1024 : 0) + tile * 128 + (rem & ~31) + perm32(rem & 31);
}
__device__ __forceinline__ void transpose_tile(const float* __restrict__ src, int ldsrc, u16* __restrict__ dst, int K,
                                               int k0, int n0, int mode, int tid) {
  extern __shared__ __attribute__((aligned(16))) unsigned char lds_raw[];
  float* tl = reinterpret_cast<float*>(lds_raw);
#pragma unroll
  for (int i = 0; i < 2; ++i) {
    int k = (tid >> 4) + 32 * i, c4 = (tid & 15) * 4;
    int np = n0 + c4;
    int n = map_col(np, mode);
    float4 v = *reinterpret_cast<const float4*>(src + (long)(k0 + k) * ldsrc + n);
    tl[k * 65 + c4 + 0] = v.x; tl[k * 65 + c4 + 1] = v.y; tl[k * 65 + c4 + 2] = v.z; tl[k * 65 + c4 + 3] = v.w;
  }
  __syncthreads();
  {
    int kc = tid & 7, np = tid >> 3;
    unsigned int w[4];
#pragma unroll
    for (int i = 0; i < 4; ++i) w[i] = pack2(tl[(kc * 8 + 2 * i) * 65 + np], tl[(kc * 8 + 2 * i + 1) * 65 + np]);
    uint4 o; o.x = w[0]; o.y = w[1]; o.z = w[2]; o.w = w[3];
    *reinterpret_cast<uint4*>(dst + (long)(n0 + np) * K + k0 + kc * 8) = o;
  }
  __syncthreads();
}

__device__ __forceinline__ void phase_prep_moe(const MP& p0) {
  extern __shared__ __attribute__((aligned(16))) unsigned char lds_raw[];
  const MP p = kparams_load(); (void)p0;
  const int tid0 = opaque_tid();
  float* tl = reinterpret_cast<float*>(lds_raw);
  const float* w_gu = p.in[25];
  const float* w_down = p.in[27];
  unsigned char* wt_gu = p.ws + WS_WT_GU;
  unsigned char* wt_down = p.ws + WS_WT_DOWN;
  const int n_gu = 32 * 256, n_down = 32 * 128, n_in = 8 * 88, n_mc = 2 * 64, n_kvw = 8 * 16;
  auto decode = [&](int t, const float*& src, int& ldsrc, unsigned char*& dst, int& k0, int& n0, int& mode, int& K) {
    K = 1024;
    if (t < n_gu) { const int e = t >> 8, r = t & 255; src = w_gu + (size_t)e * 1024 * 2048; ldsrc = 2048; dst = wt_gu + (size_t)e * 2048 * 1024; k0 = (r & 7) * 128; n0 = (r >> 3) * 64; mode = MAP_GLU; }
    else if (t < n_gu + n_down) { const int tt = t - n_gu, e = tt >> 7, r = tt & 127; src = w_down + (size_t)e * 1024 * 1024; ldsrc = 1024; dst = wt_down + (size_t)e * 1024 * 1024; k0 = (r & 7) * 128; n0 = (r >> 3) * 64; mode = MAP_PERM; }
    else if (t < n_gu + n_down + n_in) { const int r = t - n_gu - n_down; src = p.in[3]; ldsrc = 5632; dst = p.ws + WS_WT_IN; k0 = (r & 7) * 128; n0 = (r >> 3) * 64; mode = MAP_PERM; }
    else if (t < n_gu + n_down + n_in + n_mc) { const int r0 = t - n_gu - n_down - n_in, w = r0 >> 6, r = r0 & 63; src = w ? p.in[20] : p.in[15]; ldsrc = 1024; dst = p.ws + (w ? WS_WT_CO : WS_WT_MO); k0 = (r & 3) * 128; n0 = (r >> 2) * 64; mode = MAP_PERM; K = 512; }
    else { const int r = t - n_gu - n_down - n_in - n_mc; src = p.in[17]; ldsrc = 1024; dst = p.ws + WS_WT_KV; k0 = (r & 7) * 128; n0 = (r >> 3) * 64; mode = MAP_PERM; }
  };
  float4 v[4];
  auto issue = [&](int t) {
    const float* src; int ldsrc, k0, n0, mode, K; unsigned char* dst;
    decode(t, src, ldsrc, dst, k0, n0, mode, K);
    const int c4 = (tid0 & 15) * 4;
    const int n = map_col(n0 + c4, mode);
#pragma unroll
    for (int i = 0; i < 4; ++i) { const int k = (tid0 >> 4) + 32 * i; v[i] = *reinterpret_cast<const float4*>(src + (size_t)(k0 + k) * ldsrc + n); }
  };
  int t = blockIdx.x;
  const int n_all = n_gu + n_down + n_in + n_mc + n_kvw;
  if (t < n_all) issue(t);
  for (; t < n_all; t += gridDim.x) {
    const float* src; int ldsrc, k0, n0, mode, K; unsigned char* dst;
    decode(t, src, ldsrc, dst, k0, n0, mode, K);
    __syncthreads();
    {
      const int c4 = (tid0 & 15) * 4;
#pragma unroll
      for (int i = 0; i < 4; ++i) {
        const int k = (tid0 >> 4) + 32 * i;
        float* q = tl + k * 65 + (k >> 4) * 4 + c4;
        q[0] = v[i].x; q[1] = v[i].y; q[2] = v[i].z; q[3] = v[i].w;
      }
    }
    __syncthreads();
    if (t + (int)gridDim.x < n_all) issue(t + gridDim.x);
    {
      const int kc = tid0 & 7, np = tid0 >> 3;
      float f[16];
#pragma unroll
      for (int j = 0; j < 16; ++j) { const int k = kc * 16 + j; f[j] = tl[k * 65 + (k >> 4) * 4 + np] * MOE_WSCALE; }
      uint4 o;
      o.x = pack4_fp8(f[0], f[1], f[2], f[3]); o.y = pack4_fp8(f[4], f[5], f[6], f[7]);
      o.z = pack4_fp8(f[8], f[9], f[10], f[11]); o.w = pack4_fp8(f[12], f[13], f[14], f[15]);
      *reinterpret_cast<uint4*>(dst + (size_t)(n0 + np) * K + k0 + kc * 16) = o;
    }
  }
  __syncthreads();
  const float* g_ffn = p.in[22];
  const float* w_router = p.in[23];
  float* gw = reinterpret_cast<float*>(p.ws + WS_GW);
  for (int i = blockIdx.x * NTHR + tid0; i < 1024 * 32; i += gridDim.x * NTHR) gw[i] = g_ffn[i >> 5] * w_router[i];
  if (blockIdx.x == 0 && tid0 < 64) reinterpret_cast<int*>(p.ws + WS_CNT)[tid0] = 0;
}

template <bool FP8OUT>
__device__ __forceinline__ void rms_rows(const float* __restrict__ x, const float* __restrict__ g, void* __restrict__ outv,
                                         int nrows, int tid, u16* __restrict__ out16 = nullptr) {
  u16* out = reinterpret_cast<u16*>(outv);
  unsigned char* out8 = reinterpret_cast<unsigned char*>(outv);
  const int lane = tid & 63, gw = blockIdx.x * (NTHR / 64) + (tid >> 6), nw = gridDim.x * (NTHR / 64);
  float4 gg[4];
#pragma unroll
  for (int q = 0; q < 4; ++q) gg[q] = *reinterpret_cast<const float4*>(g + q * 256 + lane * 4);
  for (int row0 = gw * 4; row0 < nrows; row0 += nw * 4) {
    float4 v[4][4];
#pragma unroll
    for (int r = 0; r < 4; ++r)
#pragma unroll
      for (int q = 0; q < 4; ++q) v[r][q] = *reinterpret_cast<const float4*>(x + (size_t)(row0 + r) * 1024 + q * 256 + lane * 4);
#pragma unroll
    for (int r = 0; r < 4; ++r) {
      float ss = 0.f;
#pragma unroll
      for (int q = 0; q < 4; ++q) ss += v[r][q].x * v[r][q].x + v[r][q].y * v[r][q].y + v[r][q].z * v[r][q].z + v[r][q].w * v[r][q].w;
#pragma unroll
      for (int o = 32; o > 0; o >>= 1) ss += __shfl_xor(ss, o);
      const float rs = rsqrtf(ss * (1.0f / 1024.0f) + 1e-6f);
#pragma unroll
      for (int q = 0; q < 4; ++q) {
        if constexpr (FP8OUT) {
          *reinterpret_cast<unsigned int*>(out8 + (size_t)(row0 + r) * 1024 + q * 256 + lane * 4) =
              pack4_fp8_ns(v[r][q].x * rs * gg[q].x, v[r][q].y * rs * gg[q].y, v[r][q].z * rs * gg[q].z, v[r][q].w * rs * gg[q].w);
          if (out16) {
            uint2 o2; o2.x = pack2(v[r][q].x * rs * gg[q].x, v[r][q].y * rs * gg[q].y); o2.y = pack2(v[r][q].z * rs * gg[q].z, v[r][q].w * rs * gg[q].w);
            *reinterpret_cast<uint2*>(out16 + (size_t)(row0 + r) * 1024 + q * 256 + lane * 4) = o2;
          }
        } else {
          uint2 o2; o2.x = pack2(v[r][q].x * rs * gg[q].x, v[r][q].y * rs * gg[q].y); o2.y = pack2(v[r][q].z * rs * gg[q].z, v[r][q].w * rs * gg[q].w);
          *reinterpret_cast<uint2*>(out + (size_t)(row0 + r) * 1024 + q * 256 + lane * 4) = o2;
        }
      }
    }
  }
}

__device__ __forceinline__ void s5_tables(const MP& p, int tid);
__device__ __forceinline__ void rope_table(const MP& p, int tid);
__device__ __forceinline__ void phase_prep_mix(const MP& p0) {
  const MP p = kparams_load(); (void)p0;
  const int tid0 = opaque_tid();
  const int n0 = 128, n1 = n0 + 256, n2 = n1 + 128, n3 = n2 + 128, n4 = n3 + 256, n5 = n4 + 256;
  for (int t = blockIdx.x; t < n5; t += gridDim.x) {
    const float* src; u16* dst; int ldsrc, K, mode, r, kts;
    if (t < n0) continue;
    else if (t < n1) { src = p.in[12]; dst = (u16*)(p.ws + WS_WT_GLU); ldsrc = 2048; K = 512; mode = MAP_GLU; r = t - n0; kts = 8; }
    else if (t < n3) continue;
    else if (t < n4) { src = p.in[21]; dst = (u16*)(p.ws + WS_WT_OUT); ldsrc = 1024; K = 1024; mode = MAP_PERM; r = t - n3; kts = 16; }
    else continue;
    const int kt = r % kts, ntile = r / kts;
    transpose_tile(src, ldsrc, dst, K, kt * 64, ntile * 64, mode, tid0);
  }
  rms_rows<true>(p.in[0], p.in[2], p.ws + WS_H, TTOK, tid0);
  rms_rows<true>(p.in[1], p.in[16], p.ws + WS_MEMN, 512, tid0);
  s5_tables(p, tid0);
  rope_table(p, tid0);
  for (int i = blockIdx.x * NTHR + tid0; i < 1024 + 16; i += gridDim.x * NTHR) reinterpret_cast<int*>(p.ws + WS_MCNT)[i] = 0;
}

struct PolGemm1 {
  static constexpr bool FP8 = true, HALFN = false;
  static constexpr int EPI_VM = 16;
  struct Unit { int pm, pn; };
  typedef OpLin OA; typedef OpLin OB;
  int tid;
  __device__ __forceinline__ int nt() const { return 8; }
  __device__ __forceinline__ bool unit(int i, Unit& u) const {
    const int L = i * gridDim.x + blockIdx.x;
    if (L >= 128 * 20) return false;
    unit_order(L, 128, 20, u.pm, u.pn); if (u.pn >= 6) u.pn += 2;
    return true;
  }
  __device__ __forceinline__ void ops(const Unit& u, OA& A, OB& B) const {
    const MP p = kparams_load();
    const int tid = opaque_tid();
    A = op_plain(tid, (const u16*)(p.ws + WS_H), (long)u.pm * 256, 512);
    B = op_plain(tid, (const u16*)(p.ws + WS_WT_IN), (long)u.pn * 256, 512);
  }
  __device__ __forceinline__ void epilogue(acc_t& acc, const Unit& u) const {
    const MP p = kparams_load();
    const int te = opaque_tid(), wr = (te >> 8) & 1, wc = (te >> 6) & 3, fr = te & 15, fq = (te >> 4) & 3;
    constexpr float WSI = 1.0f / MOE_WSCALE;
    u16* proj = (u16*)(p.ws + WS_PROJ);
#pragma unroll
    for (int ai = 0; ai < 2; ++ai)
#pragma unroll
      for (int m = 0; m < 4; ++m) {
        const size_t row = (size_t)u.pm * 256 + ai * 128 + wr * 64 + m * 16 + fr;
#pragma unroll
        for (int bj = 0; bj < 2; ++bj) {
          const int col = u.pn * 256 + bj * 128 + wc * 32 + fq * 8;
          if (u.pn >= 10) {
            uint2 o;
            o.x = pack4_fp8_ns(WSI * acc[ai][bj][m][0][0], WSI * acc[ai][bj][m][0][1], WSI * acc[ai][bj][m][0][2], WSI * acc[ai][bj][m][0][3]);
            o.y = pack4_fp8_ns(WSI * acc[ai][bj][m][1][0], WSI * acc[ai][bj][m][1][1], WSI * acc[ai][bj][m][1][2], WSI * acc[ai][bj][m][1][3]);
            *reinterpret_cast<uint2*>(reinterpret_cast<unsigned char*>(proj) + row * 11264 + GATE8_OFF + (col - 2560)) = o;
          } else {
            uint4 o;
            o.x = pack2(WSI * acc[ai][bj][m][0][0], WSI * acc[ai][bj][m][0][1]); o.y = pack2(WSI * acc[ai][bj][m][0][2], WSI * acc[ai][bj][m][0][3]);
            o.z = pack2(WSI * acc[ai][bj][m][1][0], WSI * acc[ai][bj][m][1][1]); o.w = pack2(WSI * acc[ai][bj][m][1][2], WSI * acc[ai][bj][m][1][3]);
            *reinterpret_cast<uint4*>(proj + row * 5632 + col) = o;
          }
        }
      }
  }
};
struct PolGemm1U {
  static constexpr bool FP8 = false, HALFN = false;
  static constexpr int EPI_VM = 16;
  struct Unit { int pm, pn; };
  typedef OpLin OA; typedef OpLin OB;
  int tid;
  __device__ __forceinline__ int nt() const { return 16; }
  __device__ __forceinline__ bool unit(int i, Unit& u) const {
    const int L = i * gridDim.x + blockIdx.x;
    if (L >= 128 * 2) return false;
    u.pm = L >> 1; u.pn = L & 1;
    return true;
  }
  __device__ __forceinline__ void ops(const Unit& u, OA& A, OB& B) const {
    const MP p = kparams_load();
    const int tid = opaque_tid();
    A = op_plain(tid, (const u16*)(p.ws + WS_H16), (long)u.pm * 256, 1024);
    B = op_plain(tid, (const u16*)(p.ws + WS_WT_IN16), (long)u.pn * 256, 1024);
  }
  __device__ __forceinline__ void epilogue(acc_t& acc, const Unit& u) const {
    const MP p = kparams_load();
    const int te = opaque_tid(), wr = (te >> 8) & 1, wc = (te >> 6) & 3, fr = te & 15, fq = (te >> 4) & 3;
    constexpr float WSI = 1.0f;
    u16* proj = (u16*)(p.ws + WS_PROJ);
#pragma unroll
    for (int ai = 0; ai < 2; ++ai)
#pragma unroll
      for (int m = 0; m < 4; ++m) {
        const size_t row = (size_t)u.pm * 256 + ai * 128 + wr * 64 + m * 16 + fr;
#pragma unroll
        for (int bj = 0; bj < 2; ++bj) {
          const int col = u.pn * 256 + bj * 128 + wc * 32 + fq * 8;
          uint4 o;
          o.x = pack2(WSI * acc[ai][bj][m][0][0], WSI * acc[ai][bj][m][0][1]); o.y = pack2(WSI * acc[ai][bj][m][0][2], WSI * acc[ai][bj][m][0][3]);
          o.z = pack2(WSI * acc[ai][bj][m][1][0], WSI * acc[ai][bj][m][1][1]); o.w = pack2(WSI * acc[ai][bj][m][1][2], WSI * acc[ai][bj][m][1][3]);
          *reinterpret_cast<uint4*>(proj + row * 5632 + col) = o;
        }
      }
  }
};
struct PolVT {
  static constexpr bool FP8 = true, HALFN = false;
  static constexpr int EPI_VM = 16;
  struct Unit { int pm, pn; };
  typedef OpLin OA; typedef OpLin OB;
  int tid;
  __device__ __forceinline__ int nt() const { return 8; }
  __device__ __forceinline__ bool unit(int i, Unit& u) const {
    const int L = i * gridDim.x + blockIdx.x;
    if (L >= 256) return false;
    u.pm = L & 1; u.pn = L >> 1;
    return true;
  }
  __device__ __forceinline__ void ops(const Unit& u, OA& A, OB& B) const {
    const MP p = kparams_load();
    const int tid = opaque_tid();
    A = op_plain(tid, (const u16*)(p.ws + WS_WT_IN), (long)1536 + u.pm * 256, 512);
    B = op_plain(tid, (const u16*)(p.ws + WS_H), (long)u.pn * 256, 512, true);
  }
  __device__ __forceinline__ void epilogue(acc_t& acc, const Unit& u) const {
    const MP p = kparams_load();
    const int te = opaque_tid(), wr = (te >> 8) & 1, wc = (te >> 6) & 3, fr = te & 15, fq = (te >> 4) & 3;
    constexpr float WSI = 1.0f / MOE_WSCALE;
    u16* vt = (u16*)(p.ws + WS_VT);
    const int tok0 = u.pn * 256, bb = tok0 / SEQ, l0 = tok0 % SEQ;
#pragma unroll
    for (int ai = 0; ai < 2; ++ai)
#pragma unroll
      for (int m = 0; m < 4; ++m) {
        const int dslot = u.pm * 256 + ai * 128 + wr * 64 + m * 16 + fr;
        const int dg = (dslot & ~31) + perm32(dslot & 31);
        u16* vrow = vt + ((size_t)bb * 512 + dg) * SEQ + l0;
#pragma unroll
        for (int bj = 0; bj < 2; ++bj) {
          const int col = bj * 128 + wc * 32 + fq * 8;
          uint4 o;
          o.x = pack2(WSI * acc[ai][bj][m][0][0], WSI * acc[ai][bj][m][0][1]); o.y = pack2(WSI * acc[ai][bj][m][0][2], WSI * acc[ai][bj][m][0][3]);
          o.z = pack2(WSI * acc[ai][bj][m][1][0], WSI * acc[ai][bj][m][1][1]); o.w = pack2(WSI * acc[ai][bj][m][1][2], WSI * acc[ai][bj][m][1][3]);
          *reinterpret_cast<uint4*>(vrow + col) = o;
        }
      }
  }
};
struct PolKV {
  static constexpr bool FP8 = true, HALFN = false;
  static constexpr int EPI_VM = 16;
  struct Unit { int pm, pn; };
  typedef OpLin OA; typedef OpLin OB;
  int tid;
  __device__ __forceinline__ int nt() const { return 8; }
  __device__ __forceinline__ bool unit(int i, Unit& u) const {
    const int L = (int)blockIdx.x - 128;
    if (i > 0 || L < 0 || L >= 8) return false;
    u.pm = L & 1; u.pn = L >> 1;
    return true;
  }
  __device__ __forceinline__ void ops(const Unit& u, OA& A, OB& B) const {
    const MP p = kparams_load();
    A = op_plain(tid, (const u16*)(p.ws + WS_MEMN), (long)u.pm * 256, 512);
    B = op_plain(tid, (const u16*)(p.ws + WS_WT_KV), (long)u.pn * 256, 512);
  }
  __device__ __forceinline__ void epilogue(acc_t& acc, const Unit& u) const {
    const MP p = kparams_load();
    const int te = opaque_tid(), wr = (te >> 8) & 1, wc = (te >> 6) & 3, fr = te & 15, fq = (te >> 4) & 3;
    float* kraw = (float*)(p.ws + WS_KRAW);
    u16* vmt = (u16*)(p.ws + WS_VMT);
#pragma unroll
    for (int ai = 0; ai < 2; ++ai)
#pragma unroll
      for (int m = 0; m < 4; ++m) {
        const int row = u.pm * 256 + ai * 128 + wr * 64 + m * 16 + fr;
#pragma unroll
        for (int bj = 0; bj < 2; ++bj)
#pragma unroll
          for (int n = 0; n < 2; ++n)
#pragma unroll
            for (int j = 0; j < 4; ++j) {
              const int col = u.pn * 256 + bj * 128 + wc * 32 + fq * 8 + n * 4 + j;
              const float v = acc[ai][bj][m][n][j] * (1.0f / MOE_WSCALE);
              if (col < 512) kraw[row * 512 + col] = v;
              else { const int c2 = col - 512; vmt[(((size_t)(row >> 8) * 4 + (c2 >> 7)) * 128 + (c2 & 127)) * 256 + (row & 255)] = f2bf(v); }
            }
      }
  }
};
__device__ __forceinline__ void phase_gemm1(const MP& p0) {
  (void)p0;
  { PolGemm1 pol; pol.tid = opaque_tid(); gemm_stream(pol); }
  { PolVT pol; pol.tid = opaque_tid(); gemm_stream(pol); }
}
__device__ __forceinline__ void phase_kvgemm(const MP& p0) {
  (void)p0;
  { PolKV pol; pol.tid = opaque_tid(); gemm_stream(pol); }
}

__device__ __forceinline__ void s5_tables(const MP& p, int tid) {
  extern __shared__ __attribute__((aligned(16))) unsigned char lds_raw[];
  float* apr = reinterpret_cast<float*>(lds_raw);
  float* api = apr + 64;
  float* crl = api + 64;
  float* cil = crl + 64;
  float* wr_ = cil + 64;
  float* wi_ = wr_ + 1024;
  float* cre_l = wi_ + 1024;
  float* cim_l = cre_l + 1024;
  const float* lam_re = p.in[4]; const float* lam_im = p.in[5]; const float* log_dt = p.in[6];
  const float* b_re = p.in[7]; const float* b_im = p.in[8]; const float* c_re = p.in[9]; const float* c_im = p.in[10];
  u16* KT = (u16*)(p.ws + WS_KT); u16* FT = (u16*)(p.ws + WS_FT); u16* ET = (u16*)(p.ws + WS_ET);
  float* A64 = (float*)(p.ws + WS_A64);
  for (int task = blockIdx.x; task < 32 * 65; task += gridDim.x) {
    const int g = task / 65, dl = task % 65;
    __syncthreads();
    if (tid < 64) {
      const int i = g * 64 + tid;
      const float dt = expf(log_dt[g]);
      const float lr = lam_re[i], li = lam_im[i];
      const float mag = expf(lr * dt);
      float sn, cs; sincos_acc(li * dt, sn, cs);
      const float a_r = mag * cs, a_i = mag * sn;
      const float nr = a_r - 1.0f, den = lr * lr + li * li;
      crl[tid] = (nr * lr + a_i * li) / den;
      cil[tid] = (a_i * lr - nr * li) / den;
      float pr = 1.f, pi = 0.f;
      for (int k = 0; k < dl; ++k) { float nr2 = pr * a_r - pi * a_i; pi = pr * a_i + pi * a_r; pr = nr2; }
      apr[tid] = pr; api[tid] = pi;
    }
    for (int e = tid; e < 1024; e += NTHR) { cre_l[e] = c_re[(size_t)g * 1024 + e]; cim_l[e] = c_im[(size_t)g * 1024 + e]; }
    __syncthreads();
    for (int e = tid; e < 1024; e += NTHR) {
      const int pp = e >> 4;
      const float br = b_re[(size_t)g * 1024 + e], bi = b_im[(size_t)g * 1024 + e];
      const float bbr = crl[pp] * br - cil[pp] * bi, bbi = crl[pp] * bi + cil[pp] * br;
      wr_[e] = apr[pp] * bbr - api[pp] * bbi;
      wi_[e] = apr[pp] * bbi + api[pp] * bbr;
    }
    __syncthreads();
    if (dl <= 63) {
      if (tid < 256) {
        const int ho = tid >> 4, hi = tid & 15;
        float acc = 0.f;
#pragma unroll 8
        for (int pp = 0; pp < 64; ++pp) acc += cre_l[ho * 64 + pp] * wr_[pp * 16 + hi] - cim_l[ho * 64 + pp] * wi_[pp * 16 + hi];
        KT[((size_t)g * 127 + dl + 63) * 256 + tid] = f2bf(acc);
        if (dl <= 62) KT[((size_t)g * 127 + 62 - dl) * 256 + tid] = 0;
      }
      const int tau = 63 - dl;
      for (int e = tid; e < 2048; e += NTHR) {
        const int n = e >> 4, hi = e & 15, c = n >> 6, pp = n & 63;
        FT[((size_t)g * 128 + n) * 1024 + tau * 16 + hi] = f2bf(c ? wi_[pp * 16 + hi] : wr_[pp * 16 + hi]);
      }
    }
    if (dl >= 1) {
      const int t = dl - 1;
      for (int e = tid; e < 2048; e += NTHR) {
        const int ho = e >> 7, k = e & 127, c = k >> 6, pp = k & 63;
        const float cre = cre_l[ho * 64 + pp], cim = cim_l[ho * 64 + pp];
        const float v = c ? -(cre * api[pp] + cim * apr[pp]) : (cre * apr[pp] - cim * api[pp]);
        ET[((size_t)g * 1024 + t * 16 + ho) * 128 + k] = f2bf(v);
      }
    }
    if (dl == 64 && tid < 64) { A64[(g * 64 + tid) * 2] = apr[tid]; A64[(g * 64 + tid) * 2 + 1] = api[tid]; }
  }
}

__device__ __forceinline__ OpLin op_u(int tid, const u16* proj, int g, int pm) {
  OpLin o;
  o.base = reinterpret_cast<const char*>(proj + (size_t)pm * 256 * 64 * 5632 + g * 16);
#pragma unroll
  for (int i = 0; i < 2; ++i) { int R, C; stage_rc(tid * 16 + i * 8192, R, C); o.voff[i] = (unsigned)((R * 64 * 5632 + (C >> 4) * 5632 + (C & 15)) * 2); }
  o.hstep = (long)128 * 64 * 5632 * 2; o.kstep = 4 * 5632 * 2;
  return o;
}

struct PolS5S {
  static constexpr bool FP8 = false, HALFN = true;
  static constexpr int EPI_VM = 16;
  struct Unit { int g, pm, kh; };
  typedef OpLin OA; typedef OpLin OB;
  int tid;
  __device__ __forceinline__ int nt() const { return 8; }
  __device__ __forceinline__ bool unit(int i, Unit& u) const {
    const int L = i * gridDim.x + blockIdx.x;
    if (L >= 128) return false;
    u.g = L >> 2; u.pm = (L >> 1) & 1; u.kh = L & 1; return true;
  }
  __device__ __forceinline__ void ops(const Unit& u, OA& A, OB& B) const {
    const MP p = kparams_load();
    A = op_u(tid, (const u16*)(p.ws + WS_PROJ), u.g, u.pm);
    B = op_plain(tid, (const u16*)(p.ws + WS_FT) + (size_t)u.g * 128 * 1024, 0, 1024);
    A.base += u.kh * 8 * A.kstep; B.base += u.kh * 8 * B.kstep;
  }
  __device__ __forceinline__ void epilogue(acc_t& acc, const Unit& u) const {
    const MP p = kparams_load();
    const int te = opaque_tid(), wr = (te >> 8) & 1, wc = (te >> 6) & 3, fr = te & 15, fq = (te >> 4) & 3;
    float* S = (float*)(p.ws + WS_S5S) + (size_t)u.kh * 512 * 32 * 128;
#pragma unroll
    for (int ai = 0; ai < 2; ++ai)
#pragma unroll
      for (int m = 0; m < 4; ++m) {
        const size_t chunk = (size_t)u.pm * 256 + ai * 128 + wr * 64 + m * 16 + fr;
#pragma unroll
        for (int n = 0; n < 2; ++n) {
          const int col = wc * 32 + n * 16 + fq * 4;
          float4 o = make_float4(acc[ai][0][m][n][0], acc[ai][0][m][n][1], acc[ai][0][m][n][2], acc[ai][0][m][n][3]);
          *reinterpret_cast<float4*>(S + (chunk * 32 + u.g) * 128 + col) = o;
        }
      }
  }
};
__device__ __forceinline__ void phase_s5s(const MP& p0) {
  (void)p0;
  PolS5S pol; pol.tid = opaque_tid();
  gemm_stream(pol);
}

__device__ __forceinline__ void phase_s5scan(const MP& p0) {
  const MP p = kparams_load(); (void)p0;
  const int tid = opaque_tid();
  if (blockIdx.x >= 8) return;
  const int id = blockIdx.x * NTHR + tid, pp = id & 63, g = (id >> 6) & 31, b = id >> 11;
  const float* S = (const float*)(p.ws + WS_S5S);
  u16* CR = (u16*)(p.ws + WS_CARRY);
  const float* A64 = (const float*)(p.ws + WS_A64);
  const float ar = A64[(g * 64 + pp) * 2], ai = A64[(g * 64 + pp) * 2 + 1];
  float cr = 0.f, ci = 0.f;
  for (int c0 = 0; c0 < 256; c0 += 8) {
    float sr[8], si[8];
#pragma unroll
    for (int j = 0; j < 8; ++j) {
      const size_t base = (((size_t)b * 256 + c0 + j) * 32 + g) * 128;
      sr[j] = S[base + pp] + S[base + pp + (size_t)512 * 32 * 128]; si[j] = S[base + 64 + pp] + S[base + 64 + pp + (size_t)512 * 32 * 128];
    }
#pragma unroll
    for (int j = 0; j < 8; ++j) {
      const size_t base = (((size_t)b * 256 + c0 + j) * 32 + g) * 128;
      CR[base + pp] = f2bf(cr); CR[base + 64 + pp] = f2bf(ci);
      const float nr = ar * cr - ai * ci + sr[j];
      ci = ar * ci + ai * cr + si[j];
      cr = nr;
    }
  }
}

__device__ __forceinline__ void phase_s5y(const MP& p0) {
  const MP p = kparams_load(); (void)p0;
  for (int unit = blockIdx.x; unit < 256; unit += gridDim.x) {
    const int tid = opaque_tid();
    const int g = unit >> 3, pm = (unit >> 2) & 1, pn = unit & 3;
    acc_t acc;
    acc_zero(acc);
    {
      OpLin A = op_u(tid, (const u16*)(p.ws + WS_PROJ), g, pm);
      OpLin B;
      B.base = reinterpret_cast<const char*>((const u16*)(p.ws + WS_KT) + (size_t)g * 127 * 256) + ((pn * 16 + 63) * 256) * 2 - 3 * 512;
#pragma unroll
      for (int i = 0; i < 2; ++i) { int R, C; stage_rc(tid * 16 + i * 8192, R, C); B.voff[i] = (unsigned)(((R >> 4) * 256 + (R & 15) * 16) * 2 + (3 - (C >> 4)) * 512 + (C & 15) * 2); }
      B.hstep = 4096; B.kstep = -2048;
      gemm_unit<false>(tid, acc, A, B, 4 * (pn + 1));
    }
#ifndef S5Y_NOSEG2
    {
      const int tid2 = opaque_tid();
      OpLin A;
      A.base = reinterpret_cast<const char*>((const u16*)(p.ws + WS_CARRY) + ((size_t)pm * 256 * 32 + g) * 128);
#pragma unroll
      for (int i = 0; i < 2; ++i) { int R, C; stage_rc(tid2 * 16 + i * 8192, R, C); A.voff[i] = (unsigned)((R * 32 * 128 + C) * 2); }
      A.hstep = (long)128 * 32 * 128 * 2; A.kstep = 128;
      OpLin B = op_plain(tid2, (const u16*)(p.ws + WS_ET) + (size_t)g * 1024 * 128, (long)pn * 256, 128);
      gemm_unit<false>(tid2, acc, A, B, 2);
    }
#endif
    const int te = opaque_tid(), wr = (te >> 8) & 1, wc = (te >> 6) & 3, fr = te & 15, fq = (te >> 4) & 3;
    const u16* proj = (const u16*)(p.ws + WS_PROJ);
    u16* yg = (u16*)(p.ws + WS_YGELU);
    const float4 dsk = *reinterpret_cast<const float4*>(p.in[11] + g * 16 + fq * 4);
#pragma unroll
    for (int ai = 0; ai < 2; ++ai) {
      uint2 uq[4][2][2];
#pragma unroll
      for (int m = 0; m < 4; ++m) {
        const size_t chunk = (size_t)pm * 256 + ai * 128 + wr * 64 + m * 16 + fr;
#pragma unroll
        for (int bj = 0; bj < 2; ++bj)
#pragma unroll
          for (int n = 0; n < 2; ++n) {
            const size_t tok = chunk * 64 + pn * 16 + bj * 8 + wc * 2 + n;
            uq[m][bj][n] = *reinterpret_cast<const uint2*>(proj + tok * 5632 + g * 16 + fq * 4);
          }
      }
#pragma unroll
      for (int m = 0; m < 4; ++m) {
        const size_t chunk = (size_t)pm * 256 + ai * 128 + wr * 64 + m * 16 + fr;
#pragma unroll
        for (int bj = 0; bj < 2; ++bj)
#pragma unroll
          for (int n = 0; n < 2; ++n) {
            const size_t tok = chunk * 64 + pn * 16 + bj * 8 + wc * 2 + n;
            const uint2 uu = uq[m][bj][n];
            float y[4];
            y[0] = acc[ai][bj][m][n][0] + dsk.x * __uint_as_float(uu.x << 16);
            y[1] = acc[ai][bj][m][n][1] + dsk.y * __uint_as_float(uu.x & 0xffff0000u);
            y[2] = acc[ai][bj][m][n][2] + dsk.z * __uint_as_float(uu.y << 16);
            y[3] = acc[ai][bj][m][n][3] + dsk.w * __uint_as_float(uu.y & 0xffff0000u);
#pragma unroll
            for (int j = 0; j < 4; ++j) {
              const float v = y[j];
              const float inner = 0.7978845608028654f * (v + 0.044715f * v * v * v);
              const float th = 1.0f - 2.0f * __builtin_amdgcn_rcpf(__builtin_amdgcn_exp2f(2.0f * 1.4426950408889634f * inner) + 1.0f);
              y[j] = 0.5f * v * (1.0f + th);
            }
            uint2 o; o.x = pack2(y[0], y[1]); o.y = pack2(y[2], y[3]);
            *reinterpret_cast<uint2*>(yg + tok * 512 + g * 16 + fq * 4) = o;
          }
      }
      asm volatile("" ::: "memory");
    }
  }
}

__device__ __forceinline__ int queue_next(int* ctr, int tid) {
  extern __shared__ __attribute__((aligned(16))) unsigned char lds_raw[];
  volatile LAS int* slot = (volatile LAS int*)((LAS unsigned char*)lds_raw + LDS_MISC_OFF + 2048 + 64);
  __syncthreads();
  if (tid == 0) *slot = atomicAdd(ctr, 1);
  __syncthreads();
  return *slot;
}

__device__ __forceinline__ void rope_table(const MP& p, int tid) {
  extern __shared__ __attribute__((aligned(16))) unsigned char lds_raw[];
  float* invl = reinterpret_cast<float*>(lds_raw);
  float* rope = (float*)(p.ws + WS_ROPE);
  __syncthreads();
  if (tid < 32) invl[tid] = (float)pow(10000.0, -(double)tid / 32.0);
  __syncthreads();
  for (int i = blockIdx.x * NTHR + tid; i < SEQ * 32; i += gridDim.x * NTHR) {
    const int t = i >> 5, d = i & 31;
    const float inv = invl[d];
    const float ang = (float)t * inv;
    float sn, cs; sincos_acc(ang, sn, cs);
    rope[(size_t)t * 64 + d] = cs;
    rope[(size_t)t * 64 + 32 + d] = sn;
  }
}

__device__ __forceinline__ void head_norm_rope(const u16* __restrict__ src, const float* __restrict__ gg,
                                               const float* __restrict__ rp, float (&v)[64]) {
  float ss = 0.f;
#pragma unroll
  for (int c = 0; c < 8; ++c) {
    float f[8];
    unpack8(*reinterpret_cast<const uint4*>(src + c * 8), f);
#pragma unroll
    for (int j = 0; j < 8; ++j) { v[c * 8 + j] = f[j]; ss += f[j] * f[j]; }
  }
  const float r = rsqrtf(ss * (1.0f / 64.0f) + 1e-6f);
#pragma unroll
  for (int d = 0; d < 64; ++d) v[d] = v[d] * r * gg[d];
#pragma unroll
  for (int d = 0; d < 32; ++d) {
    const float cs = rp[d], sn = rp[32 + d];
    const float x1 = v[d], x2 = v[d + 32];
    v[d] = x1 * cs - x2 * sn;
    v[d + 32] = x2 * cs + x1 * sn;
  }
}
__device__ __forceinline__ void store_row64_bf16(u16* dst, const float (&v)[64]) {
#pragma unroll
  for (int c = 0; c < 8; ++c) {
    float f[8];
#pragma unroll
    for (int j = 0; j < 8; ++j) f[j] = v[c * 8 + j];
    *reinterpret_cast<uint4*>(dst + c * 8) = pack8(f);
  }
}

__device__ __forceinline__ void phase_kprep(const MP& p0) {
  extern __shared__ __attribute__((aligned(16))) unsigned char lds_raw[];
  const MP p = kparams_load(); (void)p0;
  const int tid = opaque_tid();
  float* kl = reinterpret_cast<float*>(lds_raw);
  float* part = kl + 256 * 65;
  const u16* proj = (const u16*)(p.ws + WS_PROJ);
  const float* rope = (const float*)(p.ws + WS_ROPE);
  u16* knb = (u16*)(p.ws + WS_KN);
  float* kmean = (float*)(p.ws + WS_KMEAN);
  int* qctr = reinterpret_cast<int*>(p.ws + WS_QCTR);
  for (int task = queue_next(qctr, tid); task < 16 * 32; task = queue_next(qctr, tid)) {
    const int bh = task >> 5, blk = (task & 31) * 2 + (tid >> 8), b = bh >> 3, h = bh & 7;
    const int t = blk * 256 + (tid & 255);
    float v[64];
    head_norm_rope(proj + ((size_t)b * SEQ + t) * 5632 + 1024 + h * 64, p.in[14], rope + (size_t)t * 64, v);
    store_row64_bf16(knb + ((size_t)bh * SEQ + t) * 64, v);
#pragma unroll 1
    for (int rnd = 0; rnd < 2; ++rnd) {
      __syncthreads();
      if ((tid >> 8) == rnd) {
#pragma unroll
        for (int d = 0; d < 64; ++d) kl[(tid & 255) * 65 + d] = v[d];
      }
      __syncthreads();
      {
        const int d = tid & 63, pt = tid >> 6;
        float sum = 0.f;
        for (int i = 0; i < 32; ++i) sum += kl[(pt * 32 + i) * 65 + d];
        part[pt * 64 + d] = sum;
      }
      __syncthreads();
      if (tid < 64) {
        float sum = 0.f;
#pragma unroll
        for (int i = 0; i < 8; ++i) sum += part[i * 64 + tid];
        kmean[((size_t)bh * 64 + (task & 31) * 2 + rnd) * 64 + tid] = sum * (1.0f / 256.0f);
      }
    }
  }
}

__device__ __forceinline__ int mlist_off(int j) { return j * SEQ - 128 * j * (j + 1); }

__device__ __forceinline__ void phase_kmemnorm(const MP& p0) {
  const MP p = kparams_load(); (void)p0;
  const int tid = opaque_tid();
  {
    const float* kraw = (const float*)(p.ws + WS_KRAW);
    const float* g_ck = p.in[19];
    u16* kmn = (u16*)(p.ws + WS_KMEMN);
    for (int i = blockIdx.x * NTHR + tid; i < 512 * 4 * 16; i += gridDim.x * NTHR) {
      const int sub = i & 15, rx = i >> 4, xh = rx & 3, row = rx >> 2;
      const float* src = kraw + (size_t)row * 512 + xh * 128 + sub * 8;
      float4 a = *reinterpret_cast<const float4*>(src), c = *reinterpret_cast<const float4*>(src + 4);
      float ss = a.x * a.x + a.y * a.y + a.z * a.z + a.w * a.w + c.x * c.x + c.y * c.y + c.z * c.z + c.w * c.w;
      ss += __shfl_xor(ss, 1); ss += __shfl_xor(ss, 2); ss += __shfl_xor(ss, 4); ss += __shfl_xor(ss, 8);
      const float r = rsqrtf(ss * (1.0f / 128.0f) + 1e-6f);
      const float* g = g_ck + sub * 8;
      float f[8] = {a.x * r * g[0], a.y * r * g[1], a.z * r * g[2], a.w * r * g[3], c.x * r * g[4], c.y * r * g[5], c.z * r * g[6], c.w * r * g[7]};
      *reinterpret_cast<uint4*>(kmn + (((size_t)(row >> 8) * 4 + xh) * 256 + (row & 255)) * 128 + sub * 8) = pack8(f);
    }
  }
}

__device__ __forceinline__ void phase_gate(const MP& p0, int rep = 0) {
  extern __shared__ __attribute__((aligned(16))) unsigned char lds_raw[];
  const MP p = kparams_load(); (void)p0;
  const int tid = opaque_tid();
  float* km = reinterpret_cast<float*>(lds_raw);
  int* hist = reinterpret_cast<int*>(km + 4096);
  int* gbase = hist + 64;
  const u16* proj = (const u16*)(p.ws + WS_PROJ);
  const float* rope = (const float*)(p.ws + WS_ROPE);
  u16* qnb = (u16*)(p.ws + WS_QN);
  const float* kmean = (const float*)(p.ws + WS_KMEAN);
  int* mcnt = (int*)(p.ws + WS_MCNT);
  int* mlist = (int*)(p.ws + WS_MLIST);
  int* qctr = reinterpret_cast<int*>(p.ws + WS_QCTR) + 1;
  for (int task = queue_next(qctr, tid); task < 16 * 32; task = queue_next(qctr, tid)) {
    const int bh = task & 15, c512 = 31 - (task >> 4), b = bh >> 3, h = bh & 7;
    const int t = c512 * 512 + tid, qblk = t >> 8;
    const int nblk = c512 * 2 + 1;
    __syncthreads();
    for (int i = tid; i < nblk * 64; i += NTHR) km[i] = kmean[(size_t)bh * 4096 + i];
    if (tid < 64) hist[tid] = 0;
    __syncthreads();
    float q[64];
    head_norm_rope(proj + ((size_t)b * SEQ + t) * 5632 + 512 + h * 64, p.in[13], rope + (size_t)t * 64, q);
    store_row64_bf16(qnb + ((size_t)bh * SEQ + t) * 64, q);
    float tv0 = -INFINITY, tv1 = -INFINITY, tv2 = -INFINITY;
    int ti0 = -1, ti1 = -1, ti2 = -1;
    for (int j = 0; j < qblk; ++j) {
      const float* kj = km + j * 64;
      float sacc = 0.f;
#pragma unroll
      for (int d = 0; d < 64; ++d) sacc = fmaf(q[d], kj[d], sacc);
      if (sacc > tv0) { tv2 = tv1; ti2 = ti1; tv1 = tv0; ti1 = ti0; tv0 = sacc; ti0 = j; }
      else if (sacc > tv1) { tv2 = tv1; ti2 = ti1; tv1 = sacc; ti1 = j; }
      else if (sacc > tv2) { tv2 = sacc; ti2 = j; }
    }
    if (rep) { ti0 = ti1 = ti2 = -1; }
    int lp0 = 0, lp1 = 0, lp2 = 0;
    if (ti0 >= 0) lp0 = atomicAdd(&hist[ti0], 1);
    if (ti1 >= 0) lp1 = atomicAdd(&hist[ti1], 1);
    if (ti2 >= 0) lp2 = atomicAdd(&hist[ti2], 1);
    __syncthreads();
    if (tid < 64) gbase[tid] = hist[tid] ? atomicAdd(&mcnt[bh * 64 + tid], hist[tid]) : 0;
    __syncthreads();
    int* lb = mlist + (size_t)bh * 516096;
    if (ti0 >= 0) lb[mlist_off(ti0) + gbase[ti0] + lp0] = t * 4 + 0;
    if (ti1 >= 0) lb[mlist_off(ti1) + gbase[ti1] + lp1] = t * 4 + 1;
    if (ti2 >= 0) lb[mlist_off(ti2) + gbase[ti2] + lp2] = t * 4 + 2;
  }
}

template <int DH, int NK>
__device__ __forceinline__ void attn_wave(LAS const unsigned char* ldsK, LAS const unsigned char* ldsVT,
                                          const bf16x8 (&qf)[DH / 32], int npairs, int causal_qpos, float c1, float c2,
                                          f32x4 (&o)[DH / 16], float& lsum, int fr, int fq) {
  constexpr int KROW = (DH + 8) * 2, VROW = (NK + 8) * 2;
  auto pair = [&](int i) {
    {
      f32x4 s0 = {0.f, 0.f, 0.f, 0.f}, s1 = {0.f, 0.f, 0.f, 0.f};
#pragma unroll
      for (int ks = 0; ks < DH / 32; ++ks) {
        const bf16x8 k0 = *(const LAS bf16x8*)(ldsK + ((2 * i) * 16 + fr) * KROW + (ks * 32 + fq * 8) * 2);
        const bf16x8 k1 = *(const LAS bf16x8*)(ldsK + ((2 * i + 1) * 16 + fr) * KROW + (ks * 32 + fq * 8) * 2);
        s0 = __builtin_amdgcn_mfma_f32_16x16x32_bf16(k0, qf[ks], s0, 0, 0, 0);
        s1 = __builtin_amdgcn_mfma_f32_16x16x32_bf16(k1, qf[ks], s1, 0, 0, 0);
      }
      float pv[8];
#pragma unroll
      for (int r = 0; r < 4; ++r) {
        pv[r] = __builtin_amdgcn_exp2f(fmaf(s0[r], c1, -c2));
        pv[4 + r] = __builtin_amdgcn_exp2f(fmaf(s1[r], c1, -c2));
      }
      if (causal_qpos >= 0) {
#pragma unroll
        for (int r = 0; r < 4; ++r) {
          if (32 * i + 4 * fq + r > causal_qpos) pv[r] = 0.f;
          if (32 * i + 16 + 4 * fq + r > causal_qpos) pv[4 + r] = 0.f;
        }
      }
#pragma unroll
      for (int r = 0; r < 8; ++r) lsum += pv[r];
      union { bf16x8 v; unsigned int u[4]; } pf;
      pf.u[0] = pack2(pv[0], pv[1]); pf.u[1] = pack2(pv[2], pv[3]); pf.u[2] = pack2(pv[4], pv[5]); pf.u[3] = pack2(pv[6], pv[7]);
#pragma unroll
      for (int ds = 0; ds < DH / 16; ++ds) {
        union { bf16x8 v; u32x2 h[2]; } vf;
        vf.h[0] = *(const LAS u32x2*)(ldsVT + (ds * 16 + fr) * VROW + (32 * i + 4 * fq) * 2);
        vf.h[1] = *(const LAS u32x2*)(ldsVT + (ds * 16 + fr) * VROW + (32 * i + 16 + 4 * fq) * 2);
        o[ds] = __builtin_amdgcn_mfma_f32_16x16x32_bf16(vf.v, pf.v, o[ds], 0, 0, 0);
      }
    }
  };
  if constexpr (DH == 64) {
#pragma unroll 1
    for (int i = 0; i < NK / 32; i += 2) {
      if (i < npairs) pair(i);
      if (i + 1 < npairs) pair(i + 1);
    }
  } else {
#pragma unroll 1
    for (int i = 0; i < NK / 32; ++i)
      if (i < npairs) pair(i);
  }
}

template <int DH, int NK>
__device__ __forceinline__ void attn_wave2(LAS const unsigned char* ldsK, LAS const unsigned char* ldsVT,
                                           const bf16x8 (&qa)[DH / 32], const bf16x8 (&qb)[DH / 32], int npairs, int causal, int cqa, int cqb,
                                           float c1, float c2, f32x4 (&oa)[DH / 16], f32x4 (&ob)[DH / 16], float& lsa, float& lsb, int fr, int fq) {
  constexpr int KROW = (DH + 8) * 2, VROW = (NK + 8) * 2;
#pragma unroll 1
  for (int i = 0; i < npairs; ++i) {
    f32x4 a0 = {0.f, 0.f, 0.f, 0.f}, a1 = {0.f, 0.f, 0.f, 0.f}, b0 = {0.f, 0.f, 0.f, 0.f}, b1 = {0.f, 0.f, 0.f, 0.f};
#pragma unroll
    for (int ks = 0; ks < DH / 32; ++ks) {
      const bf16x8 k0 = *(const LAS bf16x8*)(ldsK + ((2 * i) * 16 + fr) * KROW + (ks * 32 + fq * 8) * 2);
      const bf16x8 k1 = *(const LAS bf16x8*)(ldsK + ((2 * i + 1) * 16 + fr) * KROW + (ks * 32 + fq * 8) * 2);
      a0 = __builtin_amdgcn_mfma_f32_16x16x32_bf16(k0, qa[ks], a0, 0, 0, 0);
      a1 = __builtin_amdgcn_mfma_f32_16x16x32_bf16(k1, qa[ks], a1, 0, 0, 0);
      b0 = __builtin_amdgcn_mfma_f32_16x16x32_bf16(k0, qb[ks], b0, 0, 0, 0);
      b1 = __builtin_amdgcn_mfma_f32_16x16x32_bf16(k1, qb[ks], b1, 0, 0, 0);
    }
    float pa[8], pb[8];
#pragma unroll
    for (int r = 0; r < 4; ++r) {
      pa[r] = __builtin_amdgcn_exp2f(fmaf(a0[r], c1, -c2));
      pa[4 + r] = __builtin_amdgcn_exp2f(fmaf(a1[r], c1, -c2));
      pb[r] = __builtin_amdgcn_exp2f(fmaf(b0[r], c1, -c2));
      pb[4 + r] = __builtin_amdgcn_exp2f(fmaf(b1[r], c1, -c2));
    }
    if (causal) {
#pragma unroll
      for (int r = 0; r < 4; ++r) {
        const int k0i = 32 * i + 4 * fq + r, k1i = k0i + 16;
        if (k0i > cqa) pa[r] = 0.f;
        if (k1i > cqa) pa[4 + r] = 0.f;
        if (k0i > cqb) pb[r] = 0.f;
        if (k1i > cqb) pb[4 + r] = 0.f;
      }
    }
#pragma unroll
    for (int r = 0; r < 8; ++r) { lsa += pa[r]; lsb += pb[r]; }
    union { bf16x8 v; unsigned int u[4]; } fa, fb;
    fa.u[0] = pack2(pa[0], pa[1]); fa.u[1] = pack2(pa[2], pa[3]); fa.u[2] = pack2(pa[4], pa[5]); fa.u[3] = pack2(pa[6], pa[7]);
    fb.u[0] = pack2(pb[0], pb[1]); fb.u[1] = pack2(pb[2], pb[3]); fb.u[2] = pack2(pb[4], pb[5]); fb.u[3] = pack2(pb[6], pb[7]);
#pragma unroll
    for (int ds = 0; ds < DH / 16; ++ds) {
      union { bf16x8 v; u32x2 h[2]; } vf;
      vf.h[0] = *(const LAS u32x2*)(ldsVT + (ds * 16 + fr) * VROW + (32 * i + 4 * fq) * 2);
      vf.h[1] = *(const LAS u32x2*)(ldsVT + (ds * 16 + fr) * VROW + (32 * i + 16 + 4 * fq) * 2);
      oa[ds] = __builtin_amdgcn_mfma_f32_16x16x32_bf16(vf.v, fa.v, oa[ds], 0, 0, 0);
      ob[ds] = __builtin_amdgcn_mfma_f32_16x16x32_bf16(vf.v, fb.v, ob[ds], 0, 0, 0);
    }
  }
}

__device__ __forceinline__ void phase_moba(const MP& p0, int rep = 0) {
  extern __shared__ __attribute__((aligned(16))) unsigned char lds_raw[];
  const MP p = kparams_load(); (void)p0;
  const int tid = opaque_tid();
  LAS unsigned char* lds = (LAS unsigned char*)lds_raw;
  constexpr int K_OFF = 0, VT_OFF = 256 * 144, PFX_OFF = VT_OFF + 64 * 528;
  int* pfx = reinterpret_cast<int*>(lds_raw + PFX_OFF);
  float* misc = reinterpret_cast<float*>(lds_raw + PFX_OFF + 1032 * 4);
  const u16* qn = (const u16*)(p.ws + WS_QN);
  const u16* kn = (const u16*)(p.ws + WS_KN);
  const u16* vt = (const u16*)(p.ws + WS_VT);
  const int* mcnt = (const int*)(p.ws + WS_MCNT);
  const int* mlist = (const int*)(p.ws + WS_MLIST);
  u16* opart = (u16*)p.out;
  float* lpart = (float*)(p.ws + WS_LPART);
  const int wid = tid >> 6, lane = tid & 63, fr = lane & 15, fq = lane >> 4;
  if (tid < 64) {
    float mq = fabsf(p.in[13][tid]), mk = fabsf(p.in[14][tid]);
#pragma unroll
    for (int o = 32; o > 0; o >>= 1) { mq = fmaxf(mq, __shfl_xor(mq, o)); mk = fmaxf(mk, __shfl_xor(mk, o)); }
    if (tid == 0) misc[0] = 8.0f * mq * mk * 1.02f;
  }
  {
    const int a = 1 + ((mcnt[2 * tid] + 255) >> 8), b = 1 + ((mcnt[2 * tid + 1] + 255) >> 8);
    int x = a + b;
#pragma unroll
    for (int o = 1; o < 64; o <<= 1) { const int y = __shfl_up(x, o); if (lane >= o) x += y; }
    int* wsum = reinterpret_cast<int*>(misc + 4);
    if (lane == 63) wsum[wid] = x;
    __syncthreads();
    int base = 0;
    for (int w = 0; w < wid; ++w) base += wsum[w];
    const int incl = base + x;
    pfx[1 + 2 * tid] = incl - b; pfx[2 + 2 * tid] = incl;
    if (tid == 0) pfx[0] = 0;
    __syncthreads();
  }
  const float c1 = 0.125f * 1.4426950408889634f, c2 = misc[0] * 1.4426950408889634f;
  const int n_total = pfx[1024];
  struct Meta { int bh, kblk, own, cnt, ent0, ent1; };
  int* qctr = reinterpret_cast<int*>(p.ws + WS_QCTR) + 2;
  const int n_chunks = (n_total + 3) >> 2;
  for (int ch = (rep ? (int)blockIdx.x : queue_next(qctr, tid)); ch < n_chunks; ch = (rep ? ch + (int)gridDim.x : queue_next(qctr, tid))) {
  const int it0 = ch * 4, it1 = (it0 + 4 < n_total) ? it0 + 4 : n_total;
  int lcur = 0;
  { int lo = 0, hi = 1024; while (hi - lo > 1) { const int mid = (lo + hi) >> 1; if (pfx[mid] <= it0) lo = mid; else hi = mid; } lcur = lo; }
#define MOBA_E(ITEM, M) do { const int it = (ITEM); \
    while (pfx[lcur + 1] <= it) ++lcur; \
    (M).bh = lcur >> 6; (M).kblk = lcur & 63; const int ltile = it - pfx[lcur] - 1; \
    if (ltile < 0) { (M).own = 1; (M).cnt = 256; (M).ent0 = 0; (M).ent1 = 0; } \
    else { \
      (M).own = 0; (M).cnt = mcnt[lcur] - ltile * 256; \
      const int idx = wid * 32 + fr; \
      const int* lp = mlist + (size_t)(M).bh * 516096 + mlist_off((M).kblk) + ltile * 256; \
      (M).ent0 = lp[(idx < (M).cnt) ? idx : 0]; \
      (M).ent1 = lp[(idx + 16 < (M).cnt) ? idx + 16 : 0]; \
    } } while (0)
  Meta mC, mQ, mE;
  bf16x8 qCa[2], qCb[2], qQa[2], qQb[2]; u32x4 kv[8];
  int restQ = 0;
  int lds_blk = -1;
#define MOBA_Q(M, QA, QB, REST) do { \
    const int tqa_ = (M).own ? ((M).kblk * 256 + wid * 32 + fr) : ((M).ent0 >> 2); \
    const int tqb_ = (M).own ? ((M).kblk * 256 + wid * 32 + 16 + fr) : ((M).ent1 >> 2); \
    const u16* qpa = qn + ((size_t)(M).bh * SEQ + tqa_) * 64 + fq * 8; \
    const u16* qpb = qn + ((size_t)(M).bh * SEQ + tqb_) * 64 + fq * 8; \
    QA[0] = *reinterpret_cast<const bf16x8*>(qpa); \
    QA[1] = *reinterpret_cast<const bf16x8*>(qpa + 32); \
    QB[0] = *reinterpret_cast<const bf16x8*>(qpb); \
    QB[1] = *reinterpret_cast<const bf16x8*>(qpb + 32); \
    REST = ((M).bh * 64 + (M).kblk) != lds_blk; \
    if (REST) { \
      lds_blk = (M).bh * 64 + (M).kblk; \
      const u16* kb = kn + ((size_t)(M).bh * SEQ + (size_t)(M).kblk * 256) * 64; \
      const u16* vb = vt + (size_t)(M).bh * 64 * SEQ + (size_t)(M).kblk * 256; \
      _Pragma("unroll") for (int i = 0; i < 4; ++i) { \
        const int key = (tid >> 3) + 64 * i, ch = tid & 7; \
        kv[i] = *reinterpret_cast<const u32x4*>(kb + (size_t)key * 64 + ch * 8); \
        const int d = (tid >> 5) + 16 * i, ch2 = tid & 31; \
        kv[4 + i] = *reinterpret_cast<const u32x4*>(vb + (size_t)d * SEQ + ch2 * 8); \
      } \
    } } while (0)
  if (it0 < it1) {
    MOBA_E(it0, mQ);
    MOBA_Q(mQ, qQa, qQb, restQ);
    if (it0 + 1 < it1) MOBA_E(it0 + 1, mE);
  }
  for (int item = it0; item < it1; ++item) {
    mC = mQ; qCa[0] = qQa[0]; qCa[1] = qQa[1]; qCb[0] = qQb[0]; qCb[1] = qQb[1];
    const int restC = restQ;
    if (restC) {
      __syncthreads();
#pragma unroll
      for (int i = 0; i < 4; ++i) {
        const int key = (tid >> 3) + 64 * i, ch = tid & 7;
        *(LAS u32x4*)(lds + K_OFF + key * 144 + ch * 16) = kv[i];
        const int d = (tid >> 5) + 16 * i, ch2 = tid & 31;
        *(LAS u32x4*)(lds + VT_OFF + d * 528 + ch2 * 16) = kv[4 + i];
      }
      __syncthreads();
    }
    if (item + 1 < it1) { mQ = mE; MOBA_Q(mQ, qQa, qQb, restQ); }
    if (item + 2 < it1) MOBA_E(item + 2, mE);
    const int tqa = mC.own ? (mC.kblk * 256 + wid * 32 + fr) : (mC.ent0 >> 2);
    const int tqb = mC.own ? (mC.kblk * 256 + wid * 32 + 16 + fr) : (mC.ent1 >> 2);
    const int slota = mC.own ? 3 : (mC.ent0 & 3), slotb = mC.own ? 3 : (mC.ent1 & 3);
    const int valida = (wid * 32 + fr) < mC.cnt, validb = (wid * 32 + 16 + fr) < mC.cnt;
    f32x4 oa[4], ob[4];
#pragma unroll
    for (int ds = 0; ds < 4; ++ds) { oa[ds] = f32x4{0.f, 0.f, 0.f, 0.f}; ob[ds] = f32x4{0.f, 0.f, 0.f, 0.f}; }
    float lsa = 0.f, lsb = 0.f;
    const int npairs = mC.own ? (wid + 1) : 8;
    if (rep != 1) attn_wave2<64, 256>(lds + K_OFF, lds + VT_OFF, qCa, qCb, npairs, mC.own, tqa & 255, tqb & 255, c1, c2, oa, ob, lsa, lsb, fr, fq);
    lsa += __shfl_xor(lsa, 16); lsb += __shfl_xor(lsb, 16);
    lsa += __shfl_xor(lsa, 32); lsb += __shfl_xor(lsb, 32);
    if (rep == 0) {
      if (valida) {
        const size_t pidx = (((size_t)(mC.bh >> 3) * SEQ + tqa) * 8 + (mC.bh & 7)) * 4 + slota;
#pragma unroll
        for (int ds = 0; ds < 4; ++ds) {
          uint2 w; w.x = pack2(oa[ds][0], oa[ds][1]); w.y = pack2(oa[ds][2], oa[ds][3]);
          *reinterpret_cast<uint2*>(opart + pidx * 64 + ds * 16 + fq * 4) = w;
        }
        if (fq == 0) lpart[pidx] = lsa;
      }
      if (validb) {
        const size_t pidx = (((size_t)(mC.bh >> 3) * SEQ + tqb) * 8 + (mC.bh & 7)) * 4 + slotb;
#pragma unroll
        for (int ds = 0; ds < 4; ++ds) {
          uint2 w; w.x = pack2(ob[ds][0], ob[ds][1]); w.y = pack2(ob[ds][2], ob[ds][3]);
          *reinterpret_cast<uint2*>(opart + pidx * 64 + ds * 16 + fq * 4) = w;
        }
        if (fq == 0) lpart[pidx] = lsb;
      }
    }
  }
  __syncthreads();
  }
#undef MOBA_E
#undef MOBA_Q
}

__device__ __forceinline__ void phase_moba_combine(const MP& p0) {
  const MP p = kparams_load(); (void)p0;
  const int tid = opaque_tid();
  const u16* opart = (const u16*)p.out;
  const float* lpart = (const float*)(p.ws + WS_LPART);
  unsigned char* attn = p.ws + WS_ATTN;
  for (size_t i = (size_t)blockIdx.x * NTHR + tid; i < (size_t)TTOK * 8 * 8; i += (size_t)gridDim.x * NTHR) {
    const size_t th = i >> 3;
    const int c = (int)(i & 7) * 8;
    const int t = (int)((th >> 3) % SEQ);
    const int qblk = t >> 8;
    const int nsel = qblk < 3 ? qblk : 3;
    const float4 l4 = *reinterpret_cast<const float4*>(lpart + th * 4);
    const float lv[4] = {l4.x, l4.y, l4.z, l4.w};
    float acc[8] = {0.f, 0.f, 0.f, 0.f, 0.f, 0.f, 0.f, 0.f};
    float l = 0.f;
#pragma unroll
    for (int s2 = 0; s2 < 4; ++s2) {
      const bool ok = (s2 == 3) || (s2 < nsel);
      if (ok) {
        float f[8];
        unpack8(*reinterpret_cast<const uint4*>(opart + (th * 4 + s2) * 64 + c), f);
#pragma unroll
        for (int j = 0; j < 8; ++j) acc[j] += f[j];
        l += lv[s2];
      }
    }
    const float il = ATT_SCALE / l;
#pragma unroll
    for (int j = 0; j < 8; ++j) acc[j] *= il;
    uint2 o8; o8.x = pack4_fp8_ns(acc[0], acc[1], acc[2], acc[3]); o8.y = pack4_fp8_ns(acc[4], acc[5], acc[6], acc[7]);
    *reinterpret_cast<uint2*>(attn + th * 64 + c) = o8;
  }
}


__device__ __forceinline__ void phase_xattn(const MP& p0) {
  extern __shared__ __attribute__((aligned(16))) unsigned char lds_raw[];
  const MP p = kparams_load(); (void)p0;
  const int tid = opaque_tid();
  LAS unsigned char* lds = (LAS unsigned char*)lds_raw;
  constexpr int K_OFF = 0, VT_OFF = 256 * 272, MISC_OFF = 256 * 272 + 2 * 128 * 272;
  float* misc = reinterpret_cast<float*>(lds_raw + MISC_OFF);
  const u16* proj = (const u16*)(p.ws + WS_PROJ);
  const u16* kmn = (const u16*)(p.ws + WS_KMEMN);
  const u16* vmt = (const u16*)(p.ws + WS_VMT);
  const float* g_cq = p.in[18];
  unsigned char* xattn = p.ws + WS_XATTN;
  const int wid = tid >> 6, lane = tid & 63, fr = lane & 15, fq = lane >> 4;
  __syncthreads();
  if (tid < 64) {
    float mq = fmaxf(fabsf(g_cq[tid]), fabsf(g_cq[tid + 64])), mk = fmaxf(fabsf(p.in[19][tid]), fabsf(p.in[19][tid + 64]));
#pragma unroll
    for (int o = 32; o > 0; o >>= 1) { mq = fmaxf(mq, __shfl_xor(mq, o)); mk = fmaxf(mk, __shfl_xor(mk, o)); }
    if (tid == 0) misc[0] = 11.313708498984761f * mq * mk * 1.02f;
  }
  __syncthreads();
  const float c1 = 0.08838834764831845f * 1.4426950408889634f, c2 = misc[0] * 1.4426950408889634f;
  const int n_items = 2 * 4 * 64, chunk = (n_items + (int)gridDim.x - 1) / (int)gridDim.x;
  const int it0 = blockIdx.x * chunk, it1 = (it0 + chunk < n_items) ? it0 + chunk : n_items;
  int cur_bx = -1;
  for (int item = it0; item < it1; ++item) {
    const int qt = item & 63, bx = item >> 6, xh = bx & 3, b = bx >> 2;
    if (bx != cur_bx) {
      cur_bx = bx;
      __syncthreads();
      const u16* kb = kmn + (size_t)bx * 256 * 128;
      const u16* vb = vmt + (size_t)bx * 128 * 256;
#pragma unroll
      for (int i = 0; i < 8; ++i) {
        const int rrow = (tid >> 4) + 32 * i, ch = tid & 15;
        *(LAS u32x4*)(lds + K_OFF + rrow * 272 + ch * 16) = *reinterpret_cast<const u32x4*>(kb + (size_t)rrow * 128 + ch * 8);
      }
#pragma unroll
      for (int i = 0; i < 8; ++i) {
        const int d = (tid >> 5) + 16 * i, ch = tid & 31;
        *(LAS u32x4*)(lds + VT_OFF + (ch >> 4) * (128 * 272) + d * 272 + (ch & 15) * 16) = *reinterpret_cast<const u32x4*>(vb + (size_t)d * 256 + ch * 8);
      }
      __syncthreads();
    }
    const size_t tok = (size_t)b * SEQ + qt * 256 + wid * 32 + fr;
    bf16x8 qa[4], qb[4];
#define XQ_LOAD(QF, TOK) do { \
      float qv[4][8]; \
      float ss = 0.f; \
      const u16* qp = proj + (TOK) * 5632 + 2048 + xh * 128 + fq * 8; \
      _Pragma("unroll") for (int ks = 0; ks < 4; ++ks) { \
        unpack8(*reinterpret_cast<const uint4*>(qp + ks * 32), qv[ks]); \
        _Pragma("unroll") for (int j = 0; j < 8; ++j) ss += qv[ks][j] * qv[ks][j]; \
      } \
      ss += __shfl_xor(ss, 16); \
      ss += __shfl_xor(ss, 32); \
      const float r = rsqrtf(ss * (1.0f / 128.0f) + 1e-6f); \
      _Pragma("unroll") for (int ks = 0; ks < 4; ++ks) { \
        union { bf16x8 v; unsigned int u[4]; } pk; \
        _Pragma("unroll") for (int j = 0; j < 4; ++j) \
          pk.u[j] = pack2(qv[ks][2 * j] * r * g_cq[ks * 32 + fq * 8 + 2 * j], qv[ks][2 * j + 1] * r * g_cq[ks * 32 + fq * 8 + 2 * j + 1]); \
        QF[ks] = pk.v; \
      } } while (0)
    XQ_LOAD(qa, tok);
    XQ_LOAD(qb, tok + 16);
#undef XQ_LOAD
    f32x4 oa[8], ob[8];
#pragma unroll
    for (int ds = 0; ds < 8; ++ds) { oa[ds] = f32x4{0.f, 0.f, 0.f, 0.f}; ob[ds] = f32x4{0.f, 0.f, 0.f, 0.f}; }
    float lsa = 0.f, lsb = 0.f;
#pragma unroll 1
    for (int hf = 0; hf < 2; ++hf)
      attn_wave2<128, 128>(lds + K_OFF + hf * (128 * 272), lds + VT_OFF + hf * (128 * 272), qa, qb, 4, 0, 0, 0, c1, c2, oa, ob, lsa, lsb, fr, fq);
    lsa += __shfl_xor(lsa, 16); lsb += __shfl_xor(lsb, 16);
    lsa += __shfl_xor(lsa, 32); lsb += __shfl_xor(lsb, 32);
    const float ila = ATT_SCALE / lsa, ilb = ATT_SCALE / lsb;
    unsigned char* op = xattn + tok * 512 + xh * 128 + fq * 4;
#pragma unroll
    for (int ds = 0; ds < 8; ++ds) {
      *reinterpret_cast<unsigned int*>(op + ds * 16) = pack4_fp8_ns(oa[ds][0] * ila, oa[ds][1] * ila, oa[ds][2] * ila, oa[ds][3] * ila);
      *reinterpret_cast<unsigned int*>(op + 16 * 512 + ds * 16) = pack4_fp8_ns(ob[ds][0] * ilb, ob[ds][1] * ilb, ob[ds][2] * ilb, ob[ds][3] * ilb);
    }
  }
}

struct PolGlu {
  static constexpr bool FP8 = false, HALFN = false;
  static constexpr int EPI_VM = 8;
  struct Unit { int pm, pn; };
  typedef OpLin OA; typedef OpLin OB;
  int tid;
  __device__ __forceinline__ int nt() const { return 8; }
  __device__ __forceinline__ bool unit(int i, Unit& u) const {
    const int L = i * gridDim.x + blockIdx.x;
    if (L >= 128 * 8) return false;
    unit_order(L, 128, 8, u.pm, u.pn); return true;
  }
  __device__ __forceinline__ void ops(const Unit& u, OA& A, OB& B) const {
    const MP p = kparams_load();
    A = op_plain(tid, (const u16*)(p.ws + WS_YGELU), (long)u.pm * 256, 512);
    B = op_plain(tid, (const u16*)(p.ws + WS_WT_GLU), (long)u.pn * 256, 512);
  }
  __device__ __forceinline__ void epilogue(acc_t& acc, const Unit& u) const {
    const MP p = kparams_load();
    const int te = opaque_tid(), wr = (te >> 8) & 1, wc = (te >> 6) & 3, fr = te & 15, fq = (te >> 4) & 3;
    const u16* proj = (const u16*)(p.ws + WS_PROJ);
    u16* merged = (u16*)(p.ws + WS_MERGED);
    const int c0 = u.pn * 128 + wc * 32 + fq * 8;
    uint2 gq[2][4];
#pragma unroll
    for (int ai = 0; ai < 2; ++ai)
#pragma unroll
      for (int m = 0; m < 4; ++m) {
        const size_t row = (size_t)u.pm * 256 + ai * 128 + wr * 64 + m * 16 + fr;
        gq[ai][m] = *reinterpret_cast<const uint2*>(reinterpret_cast<const unsigned char*>(proj) + row * 11264 + GATE8_OFF + c0);
      }
#pragma unroll
    for (int ai = 0; ai < 2; ++ai)
#pragma unroll
      for (int m = 0; m < 4; ++m) {
        const size_t row = (size_t)u.pm * 256 + ai * 128 + wr * 64 + m * 16 + fr;
        float g[8], o[8];
        unpack8_fp8(gq[ai][m], g);
#pragma unroll
        for (int n = 0; n < 2; ++n)
#pragma unroll
          for (int j = 0; j < 4; ++j)
            o[n * 4 + j] = sigmoidf_(g[n * 4 + j]) * acc[ai][0][m][n][j] * sigmoidf_(acc[ai][1][m][n][j]);
        *reinterpret_cast<uint4*>(merged + row * 1024 + c0) = pack8(o);
      }
  }
};
__device__ __forceinline__ void phase_glu(const MP& p0) {
  (void)p0;
  PolGlu pol; pol.tid = opaque_tid();
  gemm_stream(pol);
}

struct PolMoco2 {
  static constexpr bool FP8 = true, HALFN = false;
  static constexpr int EPI_VM = 8;
  float pscale;
  struct Unit { int pm, pn, pass; };
  typedef OpLin OA; typedef OpLin OB;
  int tid;
  __device__ __forceinline__ int nt() const { return 4; }
  __device__ __forceinline__ bool unit(int i, Unit& u) const {
    const int t = i >> 1;
    const int L = t * gridDim.x + blockIdx.x;
    if (L >= 128 * 4) return false;
    unit_order(L, 128, 4, u.pm, u.pn); u.pass = i & 1; return true;
  }
  __device__ __forceinline__ void ops(const Unit& u, OA& A, OB& B) const {
    const MP p = kparams_load();
    const int tid = opaque_tid();
    A = op_plain(tid, (const u16*)(p.ws + (u.pass ? WS_XATTN : WS_ATTN)), (long)u.pm * 256, 256);
    B = op_plain(tid, (const u16*)(p.ws + (u.pass ? WS_WT_CO : WS_WT_MO)), (long)u.pn * 256, 256);
  }
  __device__ __forceinline__ void epilogue(acc_t& acc, const Unit& u) const {
    const MP p = kparams_load();
    const int te = opaque_tid(), wr = (te >> 8) & 1, wc = (te >> 6) & 3, fr = te & 15, fq = (te >> 4) & 3;
    const u16* proj = (const u16*)(p.ws + WS_PROJ);
    u16* merged = (u16*)(p.ws + WS_MERGED);
    const int goff = 2560 + 1024 + u.pass * 1024;
#pragma unroll
    for (int ai = 0; ai < 2; ++ai) {
      uint2 gq[4][2]; uint4 mq[4][2];
#pragma unroll
      for (int m = 0; m < 4; ++m) {
        const size_t row = (size_t)u.pm * 256 + ai * 128 + wr * 64 + m * 16 + fr;
#pragma unroll
        for (int bj = 0; bj < 2; ++bj) {
          const int col = u.pn * 256 + bj * 128 + wc * 32 + fq * 8;
          gq[m][bj] = *reinterpret_cast<const uint2*>(reinterpret_cast<const unsigned char*>(proj) + row * 11264 + GATE8_OFF + (goff - 2560) + col);
          mq[m][bj] = *reinterpret_cast<const uint4*>(merged + row * 1024 + col);
        }
      }
#pragma unroll
      for (int m = 0; m < 4; ++m) {
        const size_t row = (size_t)u.pm * 256 + ai * 128 + wr * 64 + m * 16 + fr;
#pragma unroll
        for (int bj = 0; bj < 2; ++bj) {
          const int col = u.pn * 256 + bj * 128 + wc * 32 + fq * 8;
          float g[8], o[8];
          unpack8_fp8(gq[m][bj], g);
          unpack8(mq[m][bj], o);
#pragma unroll
          for (int n = 0; n < 2; ++n)
#pragma unroll
            for (int j = 0; j < 4; ++j) o[n * 4 + j] += (pscale * (1.0f / (MOE_WSCALE * ATT_SCALE))) * sigmoidf_(g[n * 4 + j]) * acc[ai][bj][m][n][j];
          *reinterpret_cast<uint4*>(merged + row * 1024 + col) = pack8(o);
        }
      }
      asm volatile("" ::: "memory");
    }
  }
};
__device__ __forceinline__ void phase_moco(const MP& p0, int rep = 0) {
  (void)p0;
  PolMoco2 pol; pol.tid = opaque_tid(); pol.pscale = rep ? 0.0f : 1.0f;
  gemm_stream(pol);
}

struct PolOut {
  static constexpr bool FP8 = false, HALFN = false;
  static constexpr int EPI_VM = 16;
  struct Unit { int pm, pn; };
  typedef OpLin OA; typedef OpLin OB;
  int tid;
  __device__ __forceinline__ int nt() const { return 16; }
  __device__ __forceinline__ bool unit(int i, Unit& u) const {
    const int L = i * gridDim.x + blockIdx.x;
    if (L >= 128 * 4) return false;
    unit_order(L, 128, 4, u.pm, u.pn); return true;
  }
  __device__ __forceinline__ void ops(const Unit& u, OA& A, OB& B) const {
    const MP p = kparams_load();
    A = op_plain(tid, (const u16*)(p.ws + WS_MERGED), (long)u.pm * 256, 1024);
    B = op_plain(tid, (const u16*)(p.ws + WS_WT_OUT), (long)u.pn * 256, 1024);
  }
  __device__ __forceinline__ void epilogue(acc_t& acc, const Unit& u) const {
    const MP p = kparams_load();
    const int te = opaque_tid(), wr = (te >> 8) & 1, wc = (te >> 6) & 3, fr = te & 15, fq = (te >> 4) & 3;
    const float* x = p.in[0];
    float* out = p.out;
#pragma unroll
    for (int ai = 0; ai < 2; ++ai) {
      float4 xv[4][2][2];
#pragma unroll
      for (int m = 0; m < 4; ++m) {
        const size_t row = (size_t)u.pm * 256 + ai * 128 + wr * 64 + m * 16 + fr;
#pragma unroll
        for (int bj = 0; bj < 2; ++bj)
#pragma unroll
          for (int n = 0; n < 2; ++n)
            xv[m][bj][n] = *reinterpret_cast<const float4*>(x + row * 1024 + u.pn * 256 + bj * 128 + wc * 32 + fq * 8 + n * 4);
      }
#pragma unroll
      for (int m = 0; m < 4; ++m) {
        const size_t row = (size_t)u.pm * 256 + ai * 128 + wr * 64 + m * 16 + fr;
#pragma unroll
        for (int bj = 0; bj < 2; ++bj)
#pragma unroll
          for (int n = 0; n < 2; ++n) {
            const int col = u.pn * 256 + bj * 128 + wc * 32 + fq * 8 + n * 4;
            float4 o;
            o.x = xv[m][bj][n].x + acc[ai][bj][m][n][0]; o.y = xv[m][bj][n].y + acc[ai][bj][m][n][1];
            o.z = xv[m][bj][n].z + acc[ai][bj][m][n][2]; o.w = xv[m][bj][n].w + acc[ai][bj][m][n][3];
            *reinterpret_cast<float4*>(out + row * 1024 + col) = o;
          }
      }
      asm volatile("" ::: "memory");
    }
  }
};
__device__ __forceinline__ void phase_outproj(const MP& p0) {
  (void)p0;
  PolOut pol; pol.tid = opaque_tid();
  gemm_stream(pol);
}

__device__ __forceinline__ void phase_route(const MP& p0, int rep = 0) {
  extern __shared__ __attribute__((aligned(16))) unsigned char lds_raw[];
  const MP p = kparams_load(); (void)p0;
  const float* x1 = p.out;
  const float* g_ffn = p.in[22];
  const float* b_router = p.in[24];
  const float* gw = reinterpret_cast<const float*>(p.ws + WS_GW);
  unsigned char* h2 = p.ws + WS_H2;
  int* list = reinterpret_cast<int*>(p.ws + WS_LIST);
  float* topw = reinterpret_cast<float*>(p.ws + WS_TOPW);
  int* cnt = reinterpret_cast<int*>(p.ws + WS_CNT);
  const int tid = opaque_tid(), wid = tid >> 6, lane = tid & 63;
  float* gwl = reinterpret_cast<float*>(lds_raw);
  float* lg = reinterpret_cast<float*>(lds_raw + 131072) + wid * (16 * 33);
  int* hist = reinterpret_cast<int*>(lds_raw + 131072 + 8 * 16 * 33 * 4);
  int* gbase = hist + 32;
  const int i16 = lane & 15, kk = lane >> 4;
  __syncthreads();
  for (int i = tid; i < 8192; i += NTHR) {
    const int k = i >> 3, e4 = (i & 7) * 4;
    *reinterpret_cast<float4*>(gwl + k * 32 + (e4 ^ (((k >> 2) & 1) << 4))) = *reinterpret_cast<const float4*>(gw + (size_t)i * 4);
  }
  __syncthreads();
  for (int bt = blockIdx.x; bt < TTOK / 128; bt += gridDim.x) {
    const int tok0 = bt * 128 + wid * 16;
    if (tid < 32) hist[tid] = 0;
    __syncthreads();
    f32x4 acc0 = {0.f, 0.f, 0.f, 0.f}, acc1 = {0.f, 0.f, 0.f, 0.f};
    float ssq = 0.f;
    const float* xr = x1 + (size_t)(tok0 + i16) * 1024 + 4 * kk;
    for (int s = 0; s < 64; ++s) {
      float4 a = *reinterpret_cast<const float4*>(xr + 16 * s);
      ssq += a.x * a.x + a.y * a.y + a.z * a.z + a.w * a.w;
      const float* wb = gwl + (16 * s + 4 * kk) * 32;
      const int sw = (kk & 1) << 4;
      float av[4] = {a.x, a.y, a.z, a.w};
#pragma unroll
      for (int r = 0; r < 4; ++r) {
        float b0 = wb[r * 32 + (i16 ^ sw)], b1 = wb[r * 32 + ((i16 + 16) ^ sw)];
        acc0 = __builtin_amdgcn_mfma_f32_16x16x4f32(av[r], b0, acc0, 0, 0, 0);
        acc1 = __builtin_amdgcn_mfma_f32_16x16x4f32(av[r], b1, acc1, 0, 0, 0);
      }
    }
    ssq += __shfl_xor(ssq, 16);
    ssq += __shfl_xor(ssq, 32);
    const float rstd = rsqrtf(ssq * (1.0f / 1024.0f) + 1e-6f);
#pragma unroll
    for (int r = 0; r < 4; ++r) {
      lg[(kk * 4 + r) * 33 + i16] = acc0[r];
      lg[(kk * 4 + r) * 33 + 16 + i16] = acc1[r];
    }
    asm volatile("s_waitcnt lgkmcnt(0)" ::: "memory");
    int sel_e[4] = {0, 0, 0, 0};
    float sel_w[4] = {0.f, 0.f, 0.f, 0.f};
    int lpos[4] = {0, 0, 0, 0};
    if (lane < 16 && rep == 0) {
      float v[32];
#pragma unroll
      for (int e = 0; e < 32; ++e) v[e] = lg[lane * 33 + e] * rstd + b_router[e];
      unsigned used = 0u;
      float tv[4];
#pragma unroll
      for (int k = 0; k < 4; ++k) {
        float best = -INFINITY; int bi = 0;
#pragma unroll
        for (int e = 0; e < 32; ++e) {
          bool ok = !((used >> e) & 1u);
          if (ok && v[e] > best) { best = v[e]; bi = e; }
        }
        used |= (1u << bi);
        tv[k] = best; sel_e[k] = bi;
      }
      float e0 = 1.0f, e1 = expf(tv[1] - tv[0]), e2 = expf(tv[2] - tv[0]), e3 = expf(tv[3] - tv[0]);
      float inv = 1.0f / (e0 + e1 + e2 + e3);
      sel_w[0] = e0 * inv; sel_w[1] = e1 * inv; sel_w[2] = e2 * inv; sel_w[3] = e3 * inv;
#pragma unroll
      for (int k = 0; k < 4; ++k) lpos[k] = atomicAdd(&hist[sel_e[k]], 1);
    }
    for (int j = 0; j < 16; ++j) {
      float rs = __shfl(rstd, j);
      const float* xrow = x1 + (size_t)(tok0 + j) * 1024;
      unsigned char* hrow = h2 + (size_t)(tok0 + j) * 1024;
#pragma unroll
      for (int q = 0; q < 4; ++q) {
        int c = q * 256 + lane * 4;
        float4 a = *reinterpret_cast<const float4*>(xrow + c);
        float4 g = *reinterpret_cast<const float4*>(g_ffn + c);
        *reinterpret_cast<unsigned int*>(hrow + c) = pack4_fp8(a.x * rs * g.x, a.y * rs * g.y, a.z * rs * g.z, a.w * rs * g.w);
      }
    }
    __syncthreads();
    if (tid < 32) gbase[tid] = (hist[tid] && rep == 0) ? atomicAdd(&cnt[tid], hist[tid]) : 0;
    __syncthreads();
    if (lane < 16 && rep == 0) {
      int tok = tok0 + lane;
#pragma unroll
      for (int k = 0; k < 4; ++k) {
        int e = sel_e[k];
        list[(size_t)e * TTOK + gbase[e] + lpos[k]] = tok * 4 + k;
        topw[tok * 4 + k] = sel_w[k];
        reinterpret_cast<int*>(p.ws + WS_TOPP)[tok * 4 + k] = (e << 16) | (gbase[e] + lpos[k]);
      }
    }
    __syncthreads();
  }
}

struct MoeMap { int tilebase[33]; int rowbase[33]; int cnt[32]; unsigned char rt2e[1024]; };
__device__ __forceinline__ MoeMap* moe_map_build(const MP& p) {
  extern __shared__ __attribute__((aligned(16))) unsigned char lds_raw[];
  MoeMap* mm = reinterpret_cast<MoeMap*>(lds_raw + LDS_MISC_OFF);
  const int* cnt = reinterpret_cast<const int*>(p.ws + WS_CNT);
  if (threadIdx.x == 0) {
    int tb = 0;
    for (int e = 0; e < 32; ++e) {
      int c = cnt[e];
      mm->cnt[e] = c; mm->tilebase[e] = tb; mm->rowbase[e] = tb * 256;
      tb += (c + 255) >> 8;
    }
    mm->tilebase[32] = tb; mm->rowbase[32] = tb * 256;
  }
  __syncthreads();
  for (int t = threadIdx.x; t < mm->tilebase[32]; t += NTHR) { int e = 0; while (mm->tilebase[e + 1] <= t) ++e; mm->rt2e[t] = (unsigned char)e; }
  __syncthreads();
  return mm;
}

struct PolMoe1 {
  static constexpr bool FP8 = true, HALFN = false;
  static constexpr int EPI_VM = 0;
  struct Unit { int e, rt, ct, nvalid, rowbase, dup; int ent[2][2]; };
  typedef OpGat OA; typedef OpLin OB;
  int tid; MoeMap* mm; int total;
  __device__ __forceinline__ int nt() const { return 8; }
#ifndef DUPK
#define DUPK 1
#endif
  __device__ __forceinline__ bool unit(int i0, Unit& u) const {
    const int i = i0 / DUPK; u.dup = i0 % DUPK;
    const int sidx = i * (gridDim.x >> 3) + (blockIdx.x >> 3);
    const int rtg = (sidx >> 3) * 8 + (blockIdx.x & 7);
    const int tile = rtg * 8 + (sidx & 7);
    if (rtg >= (total >> 3)) return false;
    int e = __builtin_amdgcn_readfirstlane((int)mm->rt2e[rtg]);
    u.e = e; u.ct = tile & 7; u.rt = __builtin_amdgcn_readfirstlane(rtg - mm->tilebase[e]); u.nvalid = __builtin_amdgcn_readfirstlane(mm->cnt[e]) - u.rt * 256;
    u.rowbase = __builtin_amdgcn_readfirstlane(mm->rowbase[e]);
    const MP p = kparams_load();
    const int* le = reinterpret_cast<const int*>(p.ws + WS_LIST) + (size_t)u.e * TTOK + u.rt * 256;
#pragma unroll
    for (int i = 0; i < 2; ++i) {
      int R, C; stage_rc(tid * 16 + i * 8192, R, C);
#pragma unroll
      for (int h = 0; h < 2; ++h) { const int r = h * 128 + R; u.ent[h][i] = le[(r < u.nvalid) ? r : 0]; }
    }
    return true;
  }
  __device__ __forceinline__ void ops(const Unit& u, OA& A, OB& B) const {
    const MP p = kparams_load();
    const int tid = opaque_tid();
    A.base = reinterpret_cast<const char*>(p.ws + WS_H2); A.kstep = 128;
#pragma unroll
    for (int i = 0; i < 2; ++i) {
      int R, C; stage_rc(tid * 16 + i * 8192, R, C);
#pragma unroll
      for (int h = 0; h < 2; ++h) A.voff[h][i] = (unsigned)(((u.ent[h][i] >> 2) * 512 + C) * 2);
    }
    B = op_plain(tid, (const u16*)(p.ws + WS_WT_GU) + (size_t)u.e * 2048 * 512, u.ct * 256, 512);
#ifdef HOTK
    if (u.dup != DUPK - 1) { A.kstep = 0; B.kstep = 0; }
#endif
  }
  __device__ __forceinline__ void epilogue(acc_t& acc, const Unit& u) const {
#ifndef DUP_EPI
    if (u.dup != DUPK - 1) return;
#endif
    const MP p = kparams_load();
    const int te = opaque_tid(), wr = (te >> 8) & 1, wc = (te >> 6) & 3, fr = te & 15, fq = (te >> 4) & 3;
    const float* bg = p.in[26] + (size_t)u.e * 2048;
    unsigned char* arow = p.ws + WS_ACT + (size_t)(u.rowbase + u.rt * 256) * 1024;
    const int c0 = u.ct * 128 + wc * 32 + fq * 8;
    h16x2 bgh[4], buh[4];
#pragma unroll
    for (int q = 0; q < 4; ++q) {
      bgh[q] = h16x2{(_Float16)bg[c0 + 2 * q], (_Float16)bg[c0 + 2 * q + 1]};
      buh[q] = h16x2{(_Float16)(bg[1024 + c0 + 2 * q] + 1.0f), (_Float16)(bg[1024 + c0 + 2 * q + 1] + 1.0f)};
    }
    const h16x2 hs = h16x2{(_Float16)(1.0f / MOE_WSCALE), (_Float16)(1.0f / MOE_WSCALE)}, h7 = h16x2{(_Float16)7.f, (_Float16)7.f},
                hm6 = h16x2{(_Float16)-6.f, (_Float16)-6.f}, h8 = h16x2{(_Float16)8.f, (_Float16)8.f}, h1 = h16x2{(_Float16)1.f, (_Float16)1.f},
                hk = h16x2{(_Float16)(-1.702f * 1.4426950408889634f), (_Float16)(-1.702f * 1.4426950408889634f)};
#pragma unroll
    for (int ai = 0; ai < 2; ++ai)
#pragma unroll
      for (int m = 0; m < 4; ++m) {
        const int r = ai * 128 + wr * 64 + m * 16 + fr;
        i16x2 w01 = {0, 0}, w23 = {0, 0};
#pragma unroll
        for (int n = 0; n < 2; ++n) {
          h16x2 rr[2];
#pragma unroll
          for (int jp = 0; jp < 2; ++jp) {
            h16x2 g = __builtin_bit_cast(h16x2, __builtin_amdgcn_cvt_pkrtz(acc[ai][0][m][n][2 * jp], acc[ai][0][m][n][2 * jp + 1]));
            h16x2 u = __builtin_bit_cast(h16x2, __builtin_amdgcn_cvt_pkrtz(acc[ai][1][m][n][2 * jp], acc[ai][1][m][n][2 * jp + 1]));
            g = __builtin_elementwise_min(g * hs + bgh[n * 2 + jp], h7);
            u = __builtin_elementwise_min(__builtin_elementwise_max(u * hs + buh[n * 2 + jp], hm6), h8);
            const h16x2 arg = g * hk;
            h16x2 e; e[0] = __builtin_exp2f16(arg[0]); e[1] = __builtin_exp2f16(arg[1]);
            const h16x2 d = e + h1;
            h16x2 sg; sg[0] = __builtin_amdgcn_rcph(d[0]); sg[1] = __builtin_amdgcn_rcph(d[1]);
            rr[jp] = g * sg * u;
          }
          if (n == 0) { w01 = __builtin_amdgcn_cvt_scalef32_pk_fp8_f16(w01, rr[0], 1.0f, false); w01 = __builtin_amdgcn_cvt_scalef32_pk_fp8_f16(w01, rr[1], 1.0f, true); }
          else { w23 = __builtin_amdgcn_cvt_scalef32_pk_fp8_f16(w23, rr[0], 1.0f, false); w23 = __builtin_amdgcn_cvt_scalef32_pk_fp8_f16(w23, rr[1], 1.0f, true); }
        }
        { uint2 o8; o8.x = __builtin_bit_cast(unsigned int, w01); o8.y = __builtin_bit_cast(unsigned int, w23); *reinterpret_cast<uint2*>(arow + (size_t)r * 1024 + c0) = o8; }
      }
  }
};
__device__ __forceinline__ void phase_moe1(const MP& p0) {
  const MP p = kparams_load(); (void)p0;
#ifdef CLOCK_PROBE
  const unsigned long long c0 = clock64(), r0 = wall_clock64();
#endif
  PolMoe1 pol; pol.mm = moe_map_build(p); pol.tid = opaque_tid(); pol.total = pol.mm->tilebase[32] * 8;
  gemm_stream(pol);
#ifdef CLOCK_PROBE
  const unsigned long long c1 = clock64(), r1 = wall_clock64();
  if (blockIdx.x == 0 && threadIdx.x == 0) {
    float ghz = (float)(c1 - c0) / ((float)(r1 - r0) * 10.0f);
    reinterpret_cast<float*>(p.ws + WS_CNT)[1000] = floorf(ghz * 4.0f) * 0.25f;
  }
#endif
}

struct PolMoe2 {
  static constexpr bool FP8 = true, HALFN = false;
  static constexpr int EPI_VM = 0;
  struct Unit { int e, rt, ct, nvalid, rowbase, dup; };
  typedef OpLin OA; typedef OpLin OB;
  int tid; MoeMap* mm; int total;
  __device__ __forceinline__ int nt() const { return 8; }
#ifndef DUPK2
#define DUPK2 1
#endif
  __device__ __forceinline__ bool unit(int i0, Unit& u) const {
    const int i = i0 / DUPK2; u.dup = i0 % DUPK2;
    const int sidx = i * (gridDim.x >> 3) + (blockIdx.x >> 3);
    const int rtg = (sidx >> 2) * 8 + (blockIdx.x & 7);
    const int tile = rtg * 4 + (sidx & 3);
    if (rtg >= (total >> 2)) return false;
    int e = __builtin_amdgcn_readfirstlane((int)mm->rt2e[rtg]);
    u.e = e; u.ct = tile & 3; u.rt = __builtin_amdgcn_readfirstlane(rtg - mm->tilebase[e]); u.nvalid = __builtin_amdgcn_readfirstlane(mm->cnt[e]) - u.rt * 256;
    u.rowbase = __builtin_amdgcn_readfirstlane(mm->rowbase[e]);
    return true;
  }
  __device__ __forceinline__ void ops(const Unit& u, OA& A, OB& B) const {
    const MP p = kparams_load();
    const int tid = opaque_tid();
    A = op_plain(tid, (const u16*)(p.ws + WS_ACT), (long)u.rowbase + u.rt * 256, 512);
    B = op_plain(tid, (const u16*)(p.ws + WS_WT_DOWN) + (size_t)u.e * 1024 * 512, u.ct * 256, 512);
  }
  __device__ __forceinline__ void epilogue(acc_t& acc, const Unit& u) const {
#ifndef DUP_EPI2
    if (u.dup != DUPK2 - 1) return;
#endif
    const MP p = kparams_load();
    const int te = opaque_tid(), wr = (te >> 8) & 1, wc = (te >> 6) & 3, fr = te & 15, fq = (te >> 4) & 3;
    unsigned char* ysort = p.ws + WS_YSLOT + (size_t)(u.rowbase + u.rt * 256) * 1024;
    const float* bd = p.in[28] + (size_t)u.e * 1024;
    constexpr float WS1 = 1.0f / MOE_WSCALE;
#pragma unroll
    for (int bj = 0; bj < 2; ++bj) {
      const int col = u.ct * 256 + bj * 128 + wc * 32 + fq * 8;
      const float4 b0 = *reinterpret_cast<const float4*>(bd + col);
      const float4 b1 = *reinterpret_cast<const float4*>(bd + col + 4);
#pragma unroll
      for (int ai = 0; ai < 2; ++ai)
#pragma unroll
        for (int m = 0; m < 4; ++m) {
          const int r = ai * 128 + wr * 64 + m * 16 + fr;
          uint2 o;
          o.x = pack4_fp8_ns(WS1 * acc[ai][bj][m][0][0] + b0.x, WS1 * acc[ai][bj][m][0][1] + b0.y, WS1 * acc[ai][bj][m][0][2] + b0.z, WS1 * acc[ai][bj][m][0][3] + b0.w);
          o.y = pack4_fp8_ns(WS1 * acc[ai][bj][m][1][0] + b1.x, WS1 * acc[ai][bj][m][1][1] + b1.y, WS1 * acc[ai][bj][m][1][2] + b1.z, WS1 * acc[ai][bj][m][1][3] + b1.w);
          *reinterpret_cast<uint2*>(ysort + (size_t)r * 1024 + col) = o;
        }
    }
  }
};
__device__ __forceinline__ void phase_moe2(const MP& p0) {
  const MP p = kparams_load(); (void)p0;
  PolMoe2 pol; pol.mm = moe_map_build(p); pol.tid = opaque_tid(); pol.total = pol.mm->tilebase[32] * 4;
  gemm_stream(pol);
}

__device__ __forceinline__ void phase_moe_combine(const MP& p0, int rep = 0) {
  const MP p = kparams_load(); (void)p0;
  const int tid0 = opaque_tid();
  MoeMap* mm = moe_map_build(p);
  const unsigned char* ysort = p.ws + WS_YSLOT;
  const float* topw = reinterpret_cast<const float*>(p.ws + WS_TOPW);
  const int* topp = reinterpret_cast<const int*>(p.ws + WS_TOPP);
  float* out = p.out;
  const size_t nvec = (size_t)TTOK * 1024 / 8;
  for (size_t i = (size_t)blockIdx.x * NTHR + tid0; i < nvec; i += (size_t)gridDim.x * NTHR) {
    const size_t tok = i >> 7;
    const int c = (int)(i & 127) * 8;
    const float4 w4 = *reinterpret_cast<const float4*>(topw + tok * 4);
    const int4 p4 = *reinterpret_cast<const int4*>(topp + tok * 4);
    const float ps = rep ? 0.0f : 1.0f;
    const float wv[4] = {w4.x * ps, w4.y * ps, w4.z * ps, w4.w * ps};
    const int pv[4] = {p4.x, p4.y, p4.z, p4.w};
    float4 a = *reinterpret_cast<const float4*>(out + tok * 1024 + c);
    float4 b = *reinterpret_cast<const float4*>(out + tok * 1024 + c + 4);
    float v[8] = {a.x, a.y, a.z, a.w, b.x, b.y, b.z, b.w};
#pragma unroll
    for (int k = 0; k < 4; ++k) {
      const size_t row = (size_t)mm->rowbase[pv[k] >> 16] + (pv[k] & 0xffff);
      const uint2 y8 = *reinterpret_cast<const uint2*>(ysort + row * 1024 + c);
      const f32v2 f0 = __builtin_amdgcn_cvt_pk_f32_fp8((int)y8.x, false), f1 = __builtin_amdgcn_cvt_pk_f32_fp8((int)y8.x, true);
      const f32v2 f2 = __builtin_amdgcn_cvt_pk_f32_fp8((int)y8.y, false), f3 = __builtin_amdgcn_cvt_pk_f32_fp8((int)y8.y, true);
      v[0] = fmaf(wv[k], f0[0], v[0]); v[1] = fmaf(wv[k], f0[1], v[1]); v[2] = fmaf(wv[k], f1[0], v[2]); v[3] = fmaf(wv[k], f1[1], v[3]);
      v[4] = fmaf(wv[k], f2[0], v[4]); v[5] = fmaf(wv[k], f2[1], v[5]); v[6] = fmaf(wv[k], f3[0], v[6]); v[7] = fmaf(wv[k], f3[1], v[7]);
    }
    *reinterpret_cast<float4*>(out + tok * 1024 + c) = make_float4(v[0], v[1], v[2], v[3]);
    *reinterpret_cast<float4*>(out + tok * 1024 + c + 4) = make_float4(v[4], v[5], v[6], v[7]);
  }
}

#define XB_TMO      128
#define XB_XCNT(j)  (256  + 64 * (j))
#define XB_XSUB(j)  (1280 + 64 * (j))
#define XB_XGEN(j)  (2304 + 64 * (j))
#define XB_TOP      3328
#define XB_TOPGEN   3392
#define XCD_BAR_WORDS 3456
#define XB_SPIN_CAP (1u << 20)
#define LDS_BAR_OFF (LDS_MISC_OFF + 2048)
__device__ __forceinline__ unsigned xb_ld(unsigned* p) { return __hip_atomic_load(p, __ATOMIC_RELAXED, __HIP_MEMORY_SCOPE_AGENT); }
__device__ __forceinline__ unsigned xb_add(unsigned* p, unsigned v) { return __hip_atomic_fetch_add(p, v, __ATOMIC_RELAXED, __HIP_MEMORY_SCOPE_AGENT); }
__device__ __forceinline__ unsigned xb_xcc_id() { return (unsigned)__builtin_amdgcn_s_getreg((3 << 11) | 20) & 0xFu; }
#define XB_SPIN(cond, bar) do { unsigned _sp = 0; while (cond) { __builtin_amdgcn_s_sleep(1); \
    if ((++_sp & 255u) == 0u) { if (xb_ld(&(bar)[XB_TMO])) break; if (_sp > XB_SPIN_CAP) { atomicAdd(&(bar)[XB_TMO], 1u); break; } } } } while (0)
__device__ __forceinline__ void xcd_barrier_post() {
  extern __shared__ __attribute__((aligned(16))) unsigned char lds_raw[];
  if (threadIdx.x == 0) {
    const MP p = kparams_load();
    unsigned* bar = reinterpret_cast<unsigned*>(p.ws + WS_BAR);
    volatile LAS unsigned* st = (volatile LAS unsigned*)((LAS unsigned char*)lds_raw + LDS_BAR_OFF);
    st[0] = 0u; st[1] = 0u;
    (void)xb_add(&bar[XB_XCNT(xb_xcc_id())], 1u);
  }
  __syncthreads();
}
__device__ __forceinline__ void xcd_barrier_complete(unsigned* bar, unsigned x, unsigned& nloc, unsigned& nx) {
  const unsigned G = gridDim.x * gridDim.y * gridDim.z;
  unsigned sum, cnt, mine, sp = 0u;
  for (;;) {
    sum = 0u; cnt = 0u; mine = 0u;
#pragma unroll
    for (unsigned j = 0; j < 16; ++j) { const unsigned c = xb_ld(&bar[XB_XCNT(j)]); sum += c; cnt += (c > 0u) ? 1u : 0u; mine = (j == x) ? c : mine; }
    if (sum == G) break;
    __builtin_amdgcn_s_sleep(1);
    if ((++sp & 255u) == 0u) { if (xb_ld(&bar[XB_TMO])) break; if (sp > XB_SPIN_CAP) { atomicAdd(&bar[XB_TMO], 1u); break; } }
  }
  nloc = mine > 0u ? mine : 1u; nx = cnt > 0u ? cnt : 1u;
}
__device__ __forceinline__ void xcd_barrier() {
  extern __shared__ __attribute__((aligned(16))) unsigned char lds_raw[];
  asm volatile("s_waitcnt vmcnt(0)" ::: "memory");
  __syncthreads();
  if (threadIdx.x == 0) {
    const MP p = kparams_load();
    unsigned* bar = reinterpret_cast<unsigned*>(p.ws + WS_BAR);
    volatile LAS unsigned* st = (volatile LAS unsigned*)((LAS unsigned char*)lds_raw + LDS_BAR_OFF);
    const unsigned x = xb_xcc_id();
    __builtin_amdgcn_s_waitcnt(0);
    unsigned nloc = st[0], nx = st[1];
    if (nloc == 0u) { xcd_barrier_complete(bar, x, nloc, nx); st[0] = nloc; st[1] = nx; }
    const unsigned old = xb_add(&bar[XB_XSUB(x)], 1u);
    const unsigned gen = old / nloc;
    if (old + 1u == (gen + 1u) * nloc) {
      __builtin_amdgcn_fence(__ATOMIC_RELEASE, "agent");
      asm volatile("s_waitcnt vmcnt(0)" ::: "memory");
      const unsigned og = xb_add(&bar[XB_TOP], 1u);
      const unsigned tg = og / nx;
      if (og + 1u == (tg + 1u) * nx) xb_add(&bar[XB_TOPGEN], 1u);
      else XB_SPIN(xb_ld(&bar[XB_TOPGEN]) == tg, bar);
      __builtin_amdgcn_fence(__ATOMIC_ACQUIRE, "agent");
      xb_add(&bar[XB_XGEN(x)], 1u);
      asm volatile("s_waitcnt vmcnt(0)" ::: "memory");
    } else {
      XB_SPIN(xb_ld(&bar[XB_XGEN(x)]) == gen, bar);
      __builtin_amdgcn_fence(__ATOMIC_ACQUIRE, "agent");
      asm volatile("s_waitcnt vmcnt(0)" ::: "memory");
    }
  }
  __syncthreads();
}

enum { PH_PREP = 0, PH_GEMM1, PH_S5S_KPREP, PH_SCAN_GATE, PH_S5Y_MOBA_XATTN, PH_MOBAC_GLU, PH_MOCO, PH_OUT, PH_ROUTE, PH_MOE1, PH_MOE2,
       PH_COMBINE, PH_COUNT };

#ifndef REP_PHASE
#define REP_PHASE -1
#endif
#ifndef REP_COUNT
#define REP_COUNT 1
#endif
#ifndef ONLY
#define ONLY -1
#endif
#define SLOT(n, body) if (ONLY < 0 || ONLY == (n)) for (int _rep = 0; _rep < ((REP_PHASE == (n)) ? 1 + REP_COUNT : 1); ++_rep) { if (_rep) xcd_barrier(); body; }
__global__ void __launch_bounds__(NTHR) mega(MP p) {
  phase_prep_mix(p); __syncthreads(); phase_prep_moe(p); __syncthreads();
  xcd_barrier_post();
  xcd_barrier();
  SLOT(1, phase_gemm1(p));
  xcd_barrier();
  if (REP_PHASE == 200) { for (int q = 0; q < 20; ++q) xcd_barrier(); }
  SLOT(2, { phase_s5s(p); phase_kvgemm(p); __syncthreads(); phase_kprep(p); __syncthreads(); });
  xcd_barrier();
  SLOT(3, { phase_s5scan(p); phase_kmemnorm(p); }); __syncthreads(); phase_gate(p); if (REP_PHASE == 31) { xcd_barrier(); phase_gate(p, opaque_tid() >= 0 ? 1 : 0); }
  xcd_barrier();
  SLOT(4, phase_s5y(p)); __syncthreads(); phase_moba(p); if (REP_PHASE == 41) { xcd_barrier(); phase_moba(p, opaque_tid() >= 0 ? 1 : 0); } if (REP_PHASE == 43) { xcd_barrier(); phase_moba(p, opaque_tid() >= 0 ? 2 : 0); } __syncthreads(); SLOT(42, phase_xattn(p));
  xcd_barrier();
  SLOT(5, phase_moba_combine(p)); __syncthreads(); SLOT(51, phase_glu(p));
  xcd_barrier();
  phase_moco(p); if (REP_PHASE == 6) { xcd_barrier(); phase_moco(p, opaque_tid() >= 0 ? 1 : 0); }
  xcd_barrier();
  SLOT(7, phase_outproj(p));
  xcd_barrier();
  phase_route(p); if (REP_PHASE == 8) { xcd_barrier(); phase_route(p, opaque_tid() >= 0 ? 1 : 0); }
  xcd_barrier();
  SLOT(9, phase_moe1(p));
  xcd_barrier();
  SLOT(10, phase_moe2(p));
  xcd_barrier();
  phase_moe_combine(p); if (REP_PHASE == 11) { xcd_barrier(); phase_moe_combine(p, opaque_tid() >= 0 ? 1 : 0); }
}

extern "C" void kernel_launch(void* const* d_in, const int* in_sizes, int n_in, void* d_out, int out_size, void* d_ws,
                              size_t ws_size, hipStream_t stream) {
  (void)in_sizes; (void)out_size;
  static int grid_blocks = 0;
  if (!grid_blocks) {
    int dev = 0, cus = 0, per_cu = 0;
    (void)hipGetDevice(&dev);
    (void)hipDeviceGetAttribute(&cus, hipDeviceAttributeMultiprocessorCount, dev);
    (void)hipFuncSetAttribute((const void*)mega, hipFuncAttributeMaxDynamicSharedMemorySize, LDS_TOTAL);
    (void)hipOccupancyMaxActiveBlocksPerMultiprocessor(&per_cu, (const void*)mega, NTHR, LDS_TOTAL);
    if (per_cu < 1) { fprintf(stderr, "kernel_launch: occupancy query reports %d blocks/CU\n", per_cu); per_cu = 1; }
    grid_blocks = cus;
  }
  if (n_in != 29 || ws_size < WS_END_A) { fprintf(stderr, "kernel_launch: bad inputs (n_in %d) or workspace too small: %zu < %zu\n", n_in, ws_size, (size_t)WS_END_A); return; }
  MP mp{};
  for (int i = 0; i < 29; ++i) mp.in[i] = (const float*)d_in[i];
  mp.out = (float*)d_out;
  mp.ws = (unsigned char*)d_ws;
  mp.ph_lo = 0; mp.ph_hi = PH_COUNT;
  (void)hipMemsetAsync((unsigned char*)d_ws + WS_BAR, 0, 16384, stream);
  void* args[] = {&mp};
  hipError_t e = hipLaunchCooperativeKernel((const void*)mega, dim3(grid_blocks), dim3(NTHR), args, LDS_TOTAL, stream);
  if (e != hipSuccess) fprintf(stderr, "cooperative launch failed: %s (grid %d)\n", hipGetErrorString(e), grid_blocks);
}
```

```cpp
#include <hip/hip_runtime.h>
#include <hip/hip_cooperative_groups.h>
#include <cstdio>
#include <math.h>
#include <stdint.h>
namespace cg = cooperative_groups;

#define D_MODEL 1024
#define BATCH 2
#define SEQ 16384
#define TTOK (BATCH * SEQ)
#define IN_COLS 5632
#define NEXP 32

__device__ __forceinline__ void sincos_acc(float ang, float& s, float& c) {
  double a = (double)ang;
  double kf = rint(a * 0.6366197723675814);
  double r = fma(-kf, 1.5707963267948966, a);
  r = fma(-kf, 6.123233995736766e-17, r);
  int q = ((int)kf) & 3;
  float x = (float)r;
  float x2 = x * x;
  float sp = x + x * x2 * (-1.6666654611e-1f + x2 * (8.3321608736e-3f + x2 * (-1.9515295891e-4f)));
  float cp = 1.0f - 0.5f * x2 + x2 * x2 * (4.166664568298827e-2f + x2 * (-1.388731625493765e-3f + x2 * 2.443315711809948e-5f));
  float ss = (q & 1) ? cp : sp;
  float cc = (q & 1) ? sp : cp;
  if (q == 1 || q == 2) cc = -cc;
  if (q >= 2) ss = -ss;
  s = ss; c = cc;
}


#define NTHR 512
typedef __attribute__((ext_vector_type(8))) short bf16x8;
typedef __attribute__((ext_vector_type(4))) float f32x4;
typedef unsigned short u16;
typedef __attribute__((ext_vector_type(4))) unsigned int u32x4;
typedef __attribute__((ext_vector_type(2))) unsigned int u32x2;

typedef __bf16 bf16v2 __attribute__((ext_vector_type(2)));
typedef float f32v2 __attribute__((ext_vector_type(2)));
__device__ __forceinline__ u16 f2bf(float f) { return __builtin_bit_cast(u16, (__bf16)f); }
__device__ __forceinline__ float bf2f(u16 h) { return __uint_as_float(((unsigned int)h) << 16); }
__device__ __forceinline__ unsigned int pack2(float a, float b) { f32v2 v = {a, b}; return __builtin_bit_cast(unsigned int, __builtin_convertvector(v, bf16v2)); }

typedef int i32x8 __attribute__((ext_vector_type(8)));
typedef int i32x4 __attribute__((ext_vector_type(4)));
__device__ __forceinline__ unsigned int pack4_fp8(float a, float b, float c, float d) {
  a = fminf(fmaxf(a, -448.f), 448.f); b = fminf(fmaxf(b, -448.f), 448.f);
  c = fminf(fmaxf(c, -448.f), 448.f); d = fminf(fmaxf(d, -448.f), 448.f);
  int w = 0;
  w = __builtin_amdgcn_cvt_pk_fp8_f32(a, b, w, false);
  w = __builtin_amdgcn_cvt_pk_fp8_f32(c, d, w, true);
  return (unsigned int)w;
}
__device__ __forceinline__ unsigned int pack4_fp8_ns(float a, float b, float c, float d) {
  int w = 0;
  w = __builtin_amdgcn_cvt_pk_fp8_f32(a, b, w, false);
  w = __builtin_amdgcn_cvt_pk_fp8_f32(c, d, w, true);
  return (unsigned int)w;
}
#define MOE_WSCALE 32.0f
#define ATT_SCALE 16.0f

#define TK_ROWS (TTOK * 4)
constexpr size_t al256(size_t x) { return (x + 255) & ~(size_t)255; }
constexpr size_t WS_WT_IN = 0;
constexpr size_t WS_WT_GLU = WS_WT_IN + (size_t)5632 * 1024 * 2;
constexpr size_t WS_WT_MO = WS_WT_GLU + (size_t)2048 * 512 * 2;
constexpr size_t WS_WT_CO = WS_WT_MO + (size_t)1024 * 512 * 2;
constexpr size_t WS_WT_OUT = WS_WT_CO + (size_t)1024 * 512 * 2;
constexpr size_t WS_WT_KV = WS_WT_OUT + (size_t)1024 * 1024 * 2;
constexpr size_t WS_WT_GU = WS_WT_KV + (size_t)1024 * 1024 * 2;
constexpr size_t WS_WT_DOWN = WS_WT_GU + (size_t)32 * 2048 * 1024 * 2;
constexpr size_t WS_GW = WS_WT_DOWN + (size_t)32 * 1024 * 1024 * 2;
constexpr size_t WS_CNT = WS_GW + (size_t)1024 * 32 * 4;
constexpr size_t WS_BAR = al256(WS_CNT + 8192);
constexpr size_t WS_KT = al256(WS_BAR + 16384);
constexpr size_t WS_FT = WS_KT + (size_t)32 * 127 * 256 * 2;
constexpr size_t WS_ET = WS_FT + (size_t)32 * 128 * 1024 * 2;
constexpr size_t WS_A64 = WS_ET + (size_t)32 * 1024 * 128 * 2;
constexpr size_t WS_ROPE = al256(WS_A64 + (size_t)32 * 64 * 2 * 4);
constexpr size_t WS_M0 = al256(WS_ROPE + (size_t)SEQ * 64 * 4);
constexpr size_t WS_PROJ = WS_M0;
constexpr size_t WS_H = WS_PROJ + (size_t)TTOK * 5632 * 2;
constexpr size_t WS_UC = WS_H + (size_t)TTOK * 1024;
constexpr size_t WS_VT = WS_H + (size_t)TTOK * 1024 * 2;
constexpr size_t WS_YGELU = WS_VT + (size_t)TTOK * 512 * 2;
constexpr size_t WS_ATTN = WS_YGELU + (size_t)TTOK * 512 * 2;
constexpr size_t WS_XATTN = WS_ATTN + (size_t)TTOK * 512 * 2;
constexpr size_t WS_H16 = WS_ATTN;
constexpr size_t WS_WT_IN16 = WS_WT_IN + (size_t)6 * 1024 * 1024;
constexpr size_t WS_MERGED = WS_XATTN + (size_t)TTOK * 512 * 2;
constexpr size_t WS_MEMN = WS_MERGED + (size_t)TTOK * 1024 * 2;
constexpr size_t WS_KRAW = WS_MEMN + (size_t)512 * 1024 * 2;
constexpr size_t WS_VMT = WS_KRAW + (size_t)512 * 512 * 4;
constexpr size_t WS_S5S = WS_VMT + (size_t)512 * 512 * 2;
constexpr size_t WS_CARRY = WS_S5S + (size_t)2 * 512 * 32 * 128 * 4;
constexpr size_t WS_QN = WS_CARRY + (size_t)512 * 32 * 128 * 2;
constexpr size_t WS_KN = WS_QN + (size_t)TTOK * 512 * 2;
constexpr size_t WS_KMEAN = WS_KN + (size_t)TTOK * 512 * 2;
constexpr size_t WS_MLIST = WS_KMEAN + (size_t)16 * 64 * 64 * 4;
constexpr size_t WS_LPART = WS_MLIST + (size_t)16 * 516096 * 4;
constexpr size_t WS_KMEMN = WS_LPART + (size_t)TTOK * 8 * 4 * 4;
constexpr size_t WS_M_END = al256(WS_KMEMN + (size_t)512 * 512 * 2);
#define WS_MCNT (WS_CNT + 256)
#define WS_QCTR (WS_CNT + 256 + 4096)
constexpr size_t WS_H2 = WS_M0;
constexpr size_t WS_ACT = WS_H2 + (size_t)TTOK * 1024 * 2;
constexpr size_t WS_YSLOT = WS_ACT + (size_t)(TK_ROWS + 8192) * 1024 * 2;
constexpr size_t WS_LIST = WS_YSLOT + (size_t)(TK_ROWS + 8192) * 1024 * 2;
constexpr size_t WS_TOPW = WS_LIST + (size_t)32 * TTOK * 4;
constexpr size_t WS_TOPP = WS_TOPW + (size_t)TK_ROWS * 4;
constexpr size_t WS_E_END = al256(WS_TOPP + (size_t)TK_ROWS * 4);
constexpr size_t WS_END_A = (WS_M_END > WS_E_END ? WS_M_END : WS_E_END);

struct MP {
  const float* in[29];
  float* out;
  unsigned char* ws;
  int ph_lo, ph_hi;
};

#define LDS_GEMM_BYTES 131072
#define LDS_MISC_OFF 159744
#define LDS_TOTAL 163840

__device__ __forceinline__ int lds_byte(int r, int c) {
  int st = (r >> 4) * 2 + (c >> 5), rr = r & 15, cc = c & 31, ob = rr * 64 + cc * 2;
  return st * 1024 + (ob ^ (((ob >> 9) & 1) << 5));
}
__device__ __forceinline__ void stage_rc(int b, int& R, int& C) {
  int st = b / 1024, sb = b % 1024, swz = sb ^ (((sb >> 9) & 1) << 5);
  R = (st >> 1) * 16 + swz / 64;
  C = (st & 1) * 32 + (swz % 64) / 2;
}

#define WAIT_V(n) asm volatile("s_waitcnt vmcnt(" #n ")" ::: "memory")
#define WAIT_VN(expr) asm volatile("s_waitcnt vmcnt(%0)" ::"n"(expr) : "memory")
#define WAIT_L(n) asm volatile("s_waitcnt lgkmcnt(" #n ")" ::: "memory")
#define BAR() do { asm volatile("" ::: "memory"); __builtin_amdgcn_s_barrier(); asm volatile("" ::: "memory"); } while (0)

typedef f32x4 acc_t[2][2][4][2];
template <class T> __device__ __forceinline__ T* opaque_ptr(T* q) { asm volatile("" : "+s"(q)); return q; }
__device__ __forceinline__ int opaque_tid() { int t = threadIdx.x; asm volatile("" : "+v"(t)); return t; }

#define LAS __attribute__((address_space(3)))
#define CAS __attribute__((address_space(4)))
__device__ __forceinline__ const CAS MP* kparams() {
  auto kp = __builtin_amdgcn_kernarg_segment_ptr();
  asm volatile("" : "+s"(kp));
  return (const CAS MP*)kp;
}
__device__ __forceinline__ MP kparams_load() {
  MP r{};
#if defined(__HIP_DEVICE_COMPILE__)
  const CAS MP* k = kparams();
#pragma unroll
  for (int i = 0; i < 29; ++i) r.in[i] = k->in[i];
  r.out = k->out; r.ws = k->ws; r.ph_lo = k->ph_lo; r.ph_hi = k->ph_hi;
#endif
  return r;
}

__device__ __forceinline__ int perm32(int rho) { const int n = rho >> 4, i = rho & 15; return 8 * (i >> 2) + 4 * n + (i & 3); }

struct OpLin {
  const char* base; unsigned voff[2]; long hstep; long kstep;
  __device__ __forceinline__ const char* ptr(int h, int i, int kt) const { return base + h * hstep + kt * kstep + voff[i]; }
};
struct OpGat {
  const char* base; unsigned voff[2][2]; long kstep;
  __device__ __forceinline__ const char* ptr(int h, int i, int kt) const { return base + kt * kstep + voff[h][i]; }
};
template <bool FP8> struct Frag;
template <> struct Frag<false> { bf16x8 k[2]; };
template <> struct Frag<true> { i32x8 v; };
template <bool FP8>
__device__ __forceinline__ void frag_load(Frag<FP8>& f, const LAS unsigned char* p) {
  const bf16x8 lo = *(const LAS bf16x8*)(p), hi = *(const LAS bf16x8*)(p + 1024);
  if constexpr (FP8) f.v = __builtin_shufflevector(__builtin_bit_cast(i32x4, lo), __builtin_bit_cast(i32x4, hi), 0, 1, 2, 3, 4, 5, 6, 7);
  else { f.k[0] = lo; f.k[1] = hi; }
}
template <bool FP8>
__device__ __forceinline__ f32x4 frag_mma(const Frag<FP8>& b, const Frag<FP8>& a, f32x4 c) {
  if constexpr (FP8) return __builtin_amdgcn_mfma_scale_f32_16x16x128_f8f6f4(b.v, a.v, c, 0, 0, 0, 0x7f7f7f7f, 0, 0x7f7f7f7f);
  else {
    c = __builtin_amdgcn_mfma_f32_16x16x32_bf16(b.k[0], a.k[0], c, 0, 0, 0);
    return __builtin_amdgcn_mfma_f32_16x16x32_bf16(b.k[1], a.k[1], c, 0, 0, 0);
  }
}
struct OpLin2 {
  OpLin s0, s1; int nt0;
  __device__ __forceinline__ const char* ptr(int h, int i, int kt) const { return kt < nt0 ? s0.ptr(h, i, kt) : s1.ptr(h, i, kt - nt0); }
};
__device__ __forceinline__ OpLin op_plain(int tid, const u16* mat, long row0, long ld, bool perm = false) {
  OpLin o;
  o.base = reinterpret_cast<const char*>(mat + row0 * ld);
#pragma unroll
  for (int i = 0; i < 2; ++i) {
    int R, C; stage_rc(tid * 16 + i * 8192, R, C);
    if (perm) R = (R & ~31) + perm32(R & 31);
    o.voff[i] = (unsigned)((R * ld + C) * 2);
  }
  o.hstep = 128 * ld * 2; o.kstep = 128;
  return o;
}

template <bool FP8, class OA, class OB>
__device__ __forceinline__ void gemm_unit(int tid, acc_t& acc, const OA& A, const OB& B, int nt) {
  extern __shared__ __attribute__((aligned(16))) unsigned char lds_raw[];
  LAS unsigned char* lds = (LAS unsigned char*)lds_raw;
  const int wid = __builtin_amdgcn_readfirstlane(tid >> 6), lane = tid & 63, wr = wid >> 2, wc = wid & 3,
            fr = lane & 15, fq = lane >> 4;
  const unsigned ldsw = (unsigned)wid * 1024u;
  const int aoff = lds_byte(wr * 64 + fr, fq * 8), boff = lds_byte(wc * 32 + fr, fq * 8);
#define HTB 16384
#define G_SA(b, h) (((b) * 2 + (h)) * HTB)
#define G_SB(b, h) ((4 + (b) * 2 + (h)) * HTB)
#define G_STAGE(bufoff, OP, h, kt)                                                                                  \
  do {                                                                                                              \
    _Pragma("unroll") for (int _i = 0; _i < 2; ++_i) __builtin_amdgcn_global_load_lds(                              \
        (const unsigned*)(OP).ptr((h), _i, (kt)), (LAS unsigned*)(lds + (bufoff) + ldsw + _i * 8192), 16, 0, 0);    \
  } while (0)
#define G_LDA(dst, b, h) do { _Pragma("unroll") for (int m = 0; m < 4; ++m) frag_load<FP8>(dst[m], lds + G_SA(b, h) + aoff + m * 2048); } while (0)
#define G_LDB(dst, b, h) do { _Pragma("unroll") for (int n = 0; n < 2; ++n) frag_load<FP8>(dst[n], lds + G_SB(b, h) + boff + n * 2048); } while (0)
#define G_MM(ai, bj, At, Bt) do { __builtin_amdgcn_s_setprio(1); _Pragma("unroll") for (int m = 0; m < 4; ++m) _Pragma("unroll") for (int n = 0; n < 2; ++n) acc[ai][bj][m][n] = frag_mma<FP8>(Bt[n], At[m], acc[ai][bj][m][n]); __builtin_amdgcn_s_setprio(0); } while (0)
#define G_BAR __builtin_amdgcn_s_barrier()
#define G_SCHED __builtin_amdgcn_sched_barrier(0)
  Frag<FP8> At[4], B0[2], B1[2];
  G_STAGE(G_SB(0, 0), B, 0, 0); G_STAGE(G_SA(0, 0), A, 0, 0); G_STAGE(G_SB(0, 1), B, 1, 0); G_STAGE(G_SA(0, 1), A, 1, 0);
  if (wr == 1) G_BAR;
  WAIT_V(4); G_BAR;
  G_STAGE(G_SB(1, 0), B, 0, 1); G_STAGE(G_SA(1, 0), A, 0, 1); G_STAGE(G_SB(1, 1), B, 1, 1);
  WAIT_V(6); G_BAR;
  for (int t = 0; t < nt; t += 2) {
    const bool last = (t == nt - 2);
    const int k1 = t + 1, k2 = last ? 0 : t + 2, k3 = last ? 1 : t + 3;
    G_LDB(B0, 0, 0); G_SCHED; G_LDA(At, 0, 0); G_STAGE(G_SA(1, 1), A, 1, k1);
    WAIT_L(8); G_BAR; WAIT_L(0); G_MM(0, 0, At, B0); G_BAR; G_SCHED;
    G_LDB(B1, 0, 1); G_STAGE(G_SB(0, 0), B, 0, k2);
    G_BAR; WAIT_L(0); G_MM(0, 1, At, B1); G_BAR;
    G_LDA(At, 0, 1); G_STAGE(G_SA(0, 0), A, 0, k2);
    G_BAR; WAIT_L(0); G_MM(1, 0, At, B0); G_BAR; G_SCHED;
    G_STAGE(G_SB(0, 1), B, 1, k2);
    WAIT_V(6); G_BAR; G_MM(1, 1, At, B1); G_BAR;
    G_LDB(B0, 1, 0); G_SCHED; G_LDA(At, 1, 0); G_STAGE(G_SA(0, 1), A, 1, k2);
    WAIT_L(8); G_BAR; WAIT_L(0); G_MM(0, 0, At, B0); G_BAR; G_SCHED;
    G_LDB(B1, 1, 1); G_STAGE(G_SB(1, 0), B, 0, k3);
    G_BAR; WAIT_L(0); G_MM(0, 1, At, B1); G_BAR;
    G_LDA(At, 1, 1); G_STAGE(G_SA(1, 0), A, 0, k3);
    G_BAR; WAIT_L(0); G_MM(1, 0, At, B0); G_BAR; G_SCHED;
    G_STAGE(G_SB(1, 1), B, 1, k3);
    WAIT_V(6); G_BAR; G_MM(1, 1, At, B1); G_BAR;
  }
  WAIT_V(0);
  if (wr == 0) G_BAR;
  G_BAR;
#undef G_SA
#undef G_SB
#undef G_STAGE
#undef G_LDA
#undef G_LDB
#undef G_MM
#undef G_BAR
#undef G_SCHED
}

__device__ __forceinline__ void acc_zero(acc_t& acc) {
#pragma unroll
  for (int a = 0; a < 2; ++a)
#pragma unroll
    for (int b = 0; b < 2; ++b)
#pragma unroll
      for (int m = 0; m < 4; ++m)
#pragma unroll
        for (int n = 0; n < 2; ++n) acc[a][b][m][n] = f32x4{0.f, 0.f, 0.f, 0.f};
}

template <class P>
__device__ __forceinline__ void gemm_stream(const P& pol) {
  extern __shared__ __attribute__((aligned(16))) unsigned char lds_raw[];
  LAS unsigned char* lds = (LAS unsigned char*)lds_raw;
  const int tid = opaque_tid();
  const int wid = __builtin_amdgcn_readfirstlane(tid >> 6), lane = tid & 63, wr = wid >> 2, wc = wid & 3, fr = lane & 15, fq = lane >> 4;
  const unsigned ldsw = (unsigned)wid * 1024u;
  const int aoff = lds_byte(wr * 64 + fr, fq * 8), boff = lds_byte(wc * 32 + fr, fq * 8);
  int nt = pol.nt();
  asm volatile("" : "+s"(nt));
#define HTB 16384
#define G_SA(b, h) (((b) * 2 + (h)) * HTB)
#define G_SB(b, h) ((4 + (b) * 2 + (h)) * HTB)
#define G_STAGE(bufoff, OP, h, kt)                                                                                  \
  do {                                                                                                              \
    _Pragma("unroll") for (int _i = 0; _i < 2; ++_i) __builtin_amdgcn_global_load_lds(                              \
        (const unsigned*)(OP).ptr((h), _i, (kt)), (LAS unsigned*)(lds + (bufoff) + ldsw + _i * 8192), 16, 0, 0);    \
  } while (0)
#define G_STAGE2(bufoff, OPC, OPN, h, kt)                                                                          \
  do {                                                                                                              \
    _Pragma("unroll") for (int _i = 0; _i < 2; ++_i) {                                                              \
      const char* _pc = (OPC).ptr((h), _i, (kt));                                                                   \
      const char* _pn = (OPN).ptr((h), _i, (kt));                                                                   \
      __builtin_amdgcn_global_load_lds((const unsigned*)(last ? _pn : _pc),                                         \
                                       (LAS unsigned*)(lds + (bufoff) + ldsw + _i * 8192), 16, 0, 0);               \
    }                                                                                                               \
  } while (0)
#define G_STAGE2(bufoff, OPC, OPN, h, kt)                                                                          \
  do {                                                                                                              \
    _Pragma("unroll") for (int _i = 0; _i < 2; ++_i) {                                                              \
      const char* _pc = (OPC).ptr((h), _i, (kt));                                                                   \
      const char* _pn = (OPN).ptr((h), _i, (kt));                                                                   \
      __builtin_amdgcn_global_load_lds((const unsigned*)(last ? _pn : _pc),                                         \
                                       (LAS unsigned*)(lds + (bufoff) + ldsw + _i * 8192), 16, 0, 0);               \
    }                                                                                                               \
  } while (0)
#define G_LDA(dst, b, h) do { _Pragma("unroll") for (int m = 0; m < 4; ++m) frag_load<P::FP8>(dst[m], lds + G_SA(b, h) + aoff + m * 2048); } while (0)
#define G_LDB(dst, b, h) do { _Pragma("unroll") for (int n = 0; n < 2; ++n) frag_load<P::FP8>(dst[n], lds + G_SB(b, h) + boff + n * 2048); } while (0)
#define G_MM(ai, bj, At, Bt) do { __builtin_amdgcn_s_setprio(1); _Pragma("unroll") for (int m = 0; m < 4; ++m) _Pragma("unroll") for (int n = 0; n < 2; ++n) acc[ai][bj][m][n] = frag_mma<P::FP8>(Bt[n], At[m], acc[ai][bj][m][n]); __builtin_amdgcn_s_setprio(0); } while (0)
#define G_BAR __builtin_amdgcn_s_barrier()
#define G_SCHED __builtin_amdgcn_sched_barrier(0)
#define G_PIN do { if constexpr (P::FP8 && !P::HALFN) __builtin_amdgcn_sched_barrier(0); } while (0)
  typename P::Unit cur, nxt, nxt2;
  if (!pol.unit(0, cur)) return;
  bool has1 = pol.unit(1, nxt);
  typename P::OA A, An;
  typename P::OB B, Bn;
  pol.ops(cur, A, B);
  acc_t acc;
  acc_zero(acc);
  Frag<P::FP8> At[4], B0[2], B1[2];
  G_STAGE(G_SB(0, 0), B, 0, 0); G_STAGE(G_SA(0, 0), A, 0, 0); if constexpr (!P::HALFN) G_STAGE(G_SB(0, 1), B, 1, 0); G_STAGE(G_SA(0, 1), A, 1, 0);
  if (wr == 1) G_BAR;
  WAIT_V(0);
  G_BAR;
  G_STAGE(G_SB(1, 0), B, 0, 1); G_STAGE(G_SA(1, 0), A, 0, 1); if constexpr (!P::HALFN) G_STAGE(G_SB(1, 1), B, 1, 1);
  if constexpr (P::HALFN) WAIT_V(4); else WAIT_V(6);
  G_BAR;
  if constexpr (P::EPI_VM > 0) G_STAGE(G_SA(1, 1), A, 1, 1);
  for (int ui = 0;; ++ui) {
    const bool has_next = has1, seam = (ui > 0);
    if (has_next) pol.ops(nxt, An, Bn); else { An = A; Bn = B; }
    const bool has2 = has_next ? pol.unit(ui + 2, nxt2) : false;
    for (int t = 0; t < nt; t += 2) {
      const bool last = (t == nt - 2);
      const int k1 = t + 1, k2 = last ? 0 : t + 2, k3 = last ? 1 : t + 3;
      G_LDB(B0, 0, 0); G_SCHED; G_LDA(At, 0, 0); if constexpr (P::EPI_VM == 0) G_STAGE(G_SA(1, 1), A, 1, k1);
      WAIT_L(8); G_BAR; WAIT_L(0); G_PIN; G_MM(0, 0, At, B0); G_PIN; G_BAR; G_SCHED;
      if constexpr (!P::HALFN) G_LDB(B1, 0, 1);
      G_STAGE2(G_SB(0, 0), B, Bn, 0, k2);
      G_BAR; WAIT_L(0); if constexpr (!P::HALFN) G_PIN; G_MM(0, 1, At, B1); G_PIN;
      G_BAR;
      G_LDA(At, 0, 1); G_STAGE2(G_SA(0, 0), A, An, 0, k2);
      G_BAR; WAIT_L(0); G_PIN; G_MM(1, 0, At, B0); G_PIN; G_BAR; G_SCHED;
      if constexpr (!P::HALFN) { G_STAGE2(G_SB(0, 1), B, Bn, 1, k2); if (P::EPI_VM > 0 && seam && t == 0) WAIT_VN(6 + P::EPI_VM); else WAIT_V(6); }
      else { if (P::EPI_VM > 0 && seam && t == 0) WAIT_VN(4 + P::EPI_VM); else WAIT_V(4); }
      G_BAR; if constexpr (!P::HALFN) G_PIN; G_MM(1, 1, At, B1); G_PIN;
      G_BAR;
      G_LDB(B0, 1, 0); G_SCHED; G_LDA(At, 1, 0); G_STAGE2(G_SA(0, 1), A, An, 1, k2);
      WAIT_L(8); G_BAR; WAIT_L(0); G_PIN; G_MM(0, 0, At, B0); G_PIN; G_BAR; G_SCHED;
      if constexpr (!P::HALFN) G_LDB(B1, 1, 1);
      G_STAGE2(G_SB(1, 0), B, Bn, 0, k3);
      G_BAR; WAIT_L(0); if constexpr (!P::HALFN) G_PIN; G_MM(0, 1, At, B1); G_PIN;
      G_BAR;
      G_LDA(At, 1, 1); G_STAGE2(G_SA(1, 0), A, An, 0, k3);
      G_BAR; WAIT_L(0); G_PIN; G_MM(1, 0, At, B0); G_PIN; G_BAR; G_SCHED;
      if constexpr (!P::HALFN) { G_STAGE2(G_SB(1, 1), B, Bn, 1, k3); WAIT_V(6); } else { WAIT_V(4); }
      G_BAR; if constexpr (!P::HALFN) G_PIN; G_MM(1, 1, At, B1); G_PIN;
      if constexpr (P::EPI_VM > 0) G_STAGE2(G_SA(1, 1), A, An, 1, k3);
      G_BAR;
    }
    pol.epilogue(acc, cur);
    if (!has_next) break;
    acc_zero(acc);
    cur = nxt; nxt = nxt2; has1 = has2; A = An; B = Bn;
  }
  WAIT_V(0);
  if (wr == 0) G_BAR;
  G_BAR;
#undef G_SA
#undef G_SB
#undef G_STAGE
#undef G_STAGE2
#undef G_STAGE2
#undef G_LDA
#undef G_LDB
#undef G_MM
#undef G_BAR
#undef G_SCHED
#undef G_PIN
#undef HTB
}


__device__ __forceinline__ void unit_order(int Lin, int nM, int nN, int& pm, int& pn) {
  const int nwg = nM * nN;
  int wgid = Lin;
  { const int q = nwg / 8, r = nwg % 8, xcd = wgid % 8, off = wgid / 8; wgid = (xcd < r ? xcd * (q + 1) : r * (q + 1) + (xcd - r) * q) + off; }
  const int nig = 8 * nN, gid = wgid / nig, fm = gid * 8, gsz = (nM - fm) < 8 ? (nM - fm) : 8;
  pm = fm + ((wgid % nig) % gsz);
  pn = (wgid % nig) / gsz;
}
__device__ __forceinline__ float sigmoidf_(float x) { return __builtin_amdgcn_rcpf(1.f + __expf(-x)); }
__device__ __forceinline__ void unpack8(uint4 v, float (&f)[8]) {
  f[0] = __uint_as_float(v.x << 16); f[1] = __uint_as_float(v.x & 0xffff0000u);
  f[2] = __uint_as_float(v.y << 16); f[3] = __uint_as_float(v.y & 0xffff0000u);
  f[4] = __uint_as_float(v.z << 16); f[5] = __uint_as_float(v.z & 0xffff0000u);
  f[6] = __uint_as_float(v.w << 16); f[7] = __uint_as_float(v.w & 0xffff0000u);
}
__device__ __forceinline__ void unpack8_fp8(uint2 v, float (&f)[8]) {
  const f32v2 f0 = __builtin_amdgcn_cvt_pk_f32_fp8((int)v.x, false), f1 = __builtin_amdgcn_cvt_pk_f32_fp8((int)v.x, true);
  const f32v2 f2 = __builtin_amdgcn_cvt_pk_f32_fp8((int)v.y, false), f3 = __builtin_amdgcn_cvt_pk_f32_fp8((int)v.y, true);
  f[0] = f0[0]; f[1] = f0[1]; f[2] = f1[0]; f[3] = f1[1]; f[4] = f2[0]; f[5] = f2[1]; f[6] = f3[0]; f[7] = f3[1];
}
#define ASM_LD128(dst, ptr) asm volatile("global_load_dwordx4 %0, %1, off" : "=v"(dst) : "v"(ptr) : "memory")
#define ASM_LD64(dst, ptr) asm volatile("global_load_dwordx2 %0, %1, off" : "=v"(dst) : "v"(ptr) : "memory")
#define ASM_WAIT8(a, b, c, d, e, f, g, h) asm volatile("s_waitcnt vmcnt(0)" : "+v"(a), "+v"(b), "+v"(c), "+v"(d), "+v"(e), "+v"(f), "+v"(g), "+v"(h) :: "memory")
#define ASM_WAIT16(a, b, c, d, e, f, g, h, i, j, k, l, m, n, o, p) asm volatile("s_waitcnt vmcnt(0)" : "+v"(a), "+v"(b), "+v"(c), "+v"(d), "+v"(e), "+v"(f), "+v"(g), "+v"(h), "+v"(i), "+v"(j), "+v"(k), "+v"(l), "+v"(m), "+v"(n), "+v"(o), "+v"(p) :: "memory")
__device__ __forceinline__ uint2 as_uint2(u32x2 v) { return make_uint2(v[0], v[1]); }
__device__ __forceinline__ uint4 as_uint4(u32x4 v) { return make_uint4(v[0], v[1], v[2], v[3]); }
#define GATE8_OFF 5120
__device__ __forceinline__ uint4 pack8(const float (&f)[8]) {
  uint4 o; o.x = pack2(f[0], f[1]); o.y = pack2(f[2], f[3]); o.z = pack2(f[4], f[5]); o.w = pack2(f[6], f[7]); return o;
}
enum { MAP_PERM = 0, MAP_GLU = 1, MAP_GLU128 = 2 };
__device__ __forceinline__ int map_col(int np, int mode) {
  if (mode == MAP_PERM) return (np & ~31) + perm32(np & 31);
  if (mode == MAP_GLU128) { const int tile = np >> 7, sl = np & 127; return ((sl >> 4) & 1 ? 1024 : 0) + tile * 64 + (sl >> 5) * 16 + (sl & 15); }
  int tile = np >> 8, s = np & 255, bj = s >> 7, rem = s & 127;
  return (bj ? 1024 : 0) + tile * 128 + (rem & ~31) + perm32(rem & 31);
}
__device__ __forceinline__ void transpose_tile(const float* __restrict__ src, int ldsrc, u16* __restrict__ dst, int K,
                                               int k0, int n0, int mode, int tid) {
  extern __shared__ __attribute__((aligned(16))) unsigned char lds_raw[];
  float* tl = reinterpret_cast<float*>(lds_raw);
#pragma unroll
  for (int i = 0; i < 2; ++i) {
    int k = (tid >> 4) + 32 * i, c4 = (tid & 15) * 4;
    int np = n0 + c4;
    int n = map_col(np, mode);
    float4 v = *reinterpret_cast<const float4*>(src + (long)(k0 + k) * ldsrc + n);
    tl[k * 65 + c4 + 0] = v.x; tl[k * 65 + c4 + 1] = v.y; tl[k * 65 + c4 + 2] = v.z; tl[k * 65 + c4 + 3] = v.w;
  }
  __syncthreads();
  {
    int kc = tid & 7, np = tid >> 3;
    unsigned int w[4];
#pragma unroll
    for (int i = 0; i < 4; ++i) w[i] = pack2(tl[(kc * 8 + 2 * i) * 65 + np], tl[(kc * 8 + 2 * i + 1) * 65 + np]);
    uint4 o; o.x = w[0]; o.y = w[1]; o.z = w[2]; o.w = w[3];
    *reinterpret_cast<uint4*>(dst + (long)(n0 + np) * K + k0 + kc * 8) = o;
  }
  __syncthreads();
}

__device__ __forceinline__ void phase_prep_moe(const MP& p0) {
  extern __shared__ __attribute__((aligned(16))) unsigned char lds_raw[];
  const MP p = kparams_load(); (void)p0;
  const int tid0 = opaque_tid();
  float* tl = reinterpret_cast<float*>(lds_raw);
  const float* w_gu = p.in[25];
  const float* w_down = p.in[27];
  unsigned char* wt_gu = p.ws + WS_WT_GU;
  unsigned char* wt_down = p.ws + WS_WT_DOWN;
  const int n_gu = 32 * 256, n_down = 32 * 128, n_in = 8 * 88, n_mc = 2 * 64, n_kvw = 8 * 16;
  auto decode = [&](int t, const float*& src, int& ldsrc, unsigned char*& dst, int& k0, int& n0, int& mode, int& K) {
    K = 1024;
    if (t < n_gu) { const int e = t >> 8, r = t & 255; src = w_gu + (size_t)e * 1024 * 2048; ldsrc = 2048; dst = wt_gu + (size_t)e * 2048 * 1024; k0 = (r & 7) * 128; n0 = (r >> 3) * 64; mode = MAP_GLU; }
    else if (t < n_gu + n_down) { const int tt = t - n_gu, e = tt >> 7, r = tt & 127; src = w_down + (size_t)e * 1024 * 1024; ldsrc = 1024; dst = wt_down + (size_t)e * 1024 * 1024; k0 = (r & 7) * 128; n0 = (r >> 3) * 64; mode = MAP_PERM; }
    else if (t < n_gu + n_down + n_in) { const int r = t - n_gu - n_down; src = p.in[3]; ldsrc = 5632; dst = p.ws + WS_WT_IN; k0 = (r & 7) * 128; n0 = (r >> 3) * 64; mode = MAP_PERM; }
    else if (t < n_gu + n_down + n_in + n_mc) { const int r0 = t - n_gu - n_down - n_in, w = r0 >> 6, r = r0 & 63; src = w ? p.in[20] : p.in[15]; ldsrc = 1024; dst = p.ws + (w ? WS_WT_CO : WS_WT_MO); k0 = (r & 3) * 128; n0 = (r >> 2) * 64; mode = MAP_PERM; K = 512; }
    else { const int r = t - n_gu - n_down - n_in - n_mc; src = p.in[17]; ldsrc = 1024; dst = p.ws + WS_WT_KV; k0 = (r & 7) * 128; n0 = (r >> 3) * 64; mode = MAP_PERM; }
  };
  float4 v[4];
  auto issue = [&](int t) {
    const float* src; int ldsrc, k0, n0, mode, K; unsigned char* dst;
    decode(t, src, ldsrc, dst, k0, n0, mode, K);
    const int c4 = (tid0 & 15) * 4;
    const int n = map_col(n0 + c4, mode);
#pragma unroll
    for (int i = 0; i < 4; ++i) { const int k = (tid0 >> 4) + 32 * i; v[i] = *reinterpret_cast<const float4*>(src + (size_t)(k0 + k) * ldsrc + n); }
  };
  int t = blockIdx.x;
  const int n_all = n_gu + n_down + n_in + n_mc + n_kvw;
  if (t < n_all) issue(t);
  for (; t < n_all; t += gridDim.x) {
    const float* src; int ldsrc, k0, n0, mode, K; unsigned char* dst;
    decode(t, src, ldsrc, dst, k0, n0, mode, K);
    __syncthreads();
    {
      const int c4 = (tid0 & 15) * 4;
#pragma unroll
      for (int i = 0; i < 4; ++i) {
        const int k = (tid0 >> 4) + 32 * i;
        float* q = tl + k * 65 + (k >> 4) * 4 + c4;
        q[0] = v[i].x; q[1] = v[i].y; q[2] = v[i].z; q[3] = v[i].w;
      }
    }
    __syncthreads();
    if (t + (int)gridDim.x < n_all) issue(t + gridDim.x);
    {
      const int kc = tid0 & 7, np = tid0 >> 3;
      float f[16];
#pragma unroll
      for (int j = 0; j < 16; ++j) { const int k = kc * 16 + j; f[j] = tl[k * 65 + (k >> 4) * 4 + np] * MOE_WSCALE; }
      uint4 o;
      o.x = pack4_fp8(f[0], f[1], f[2], f[3]); o.y = pack4_fp8(f[4], f[5], f[6], f[7]);
      o.z = pack4_fp8(f[8], f[9], f[10], f[11]); o.w = pack4_fp8(f[12], f[13], f[14], f[15]);
      *reinterpret_cast<uint4*>(dst + (size_t)(n0 + np) * K + k0 + kc * 16) = o;
    }
  }
  __syncthreads();
  const float* g_ffn = p.in[22];
  const float* w_router = p.in[23];
  float* gw = reinterpret_cast<float*>(p.ws + WS_GW);
  for (int i = blockIdx.x * NTHR + tid0; i < 1024 * 32; i += gridDim.x * NTHR) gw[i] = g_ffn[i >> 5] * w_router[i];
  if (blockIdx.x == 0 && tid0 < 64) reinterpret_cast<int*>(p.ws + WS_CNT)[tid0] = 0;
}

template <bool FP8OUT>
__device__ __forceinline__ void rms_rows(const float* __restrict__ x, const float* __restrict__ g, void* __restrict__ outv,
                                         int nrows, int tid, u16* __restrict__ out16 = nullptr) {
  u16* out = reinterpret_cast<u16*>(outv);
  unsigned char* out8 = reinterpret_cast<unsigned char*>(outv);
  const int lane = tid & 63, gw = blockIdx.x * (NTHR / 64) + (tid >> 6), nw = gridDim.x * (NTHR / 64);
  float4 gg[4];
#pragma unroll
  for (int q = 0; q < 4; ++q) gg[q] = *reinterpret_cast<const float4*>(g + q * 256 + lane * 4);
  for (int row0 = gw * 4; row0 < nrows; row0 += nw * 4) {
    float4 v[4][4];
#pragma unroll
    for (int r = 0; r < 4; ++r)
#pragma unroll
      for (int q = 0; q < 4; ++q) v[r][q] = *reinterpret_cast<const float4*>(x + (size_t)(row0 + r) * 1024 + q * 256 + lane * 4);
#pragma unroll
    for (int r = 0; r < 4; ++r) {
      float ss = 0.f;
#pragma unroll
      for (int q = 0; q < 4; ++q) ss += v[r][q].x * v[r][q].x + v[r][q].y * v[r][q].y + v[r][q].z * v[r][q].z + v[r][q].w * v[r][q].w;
#pragma unroll
      for (int o = 32; o > 0; o >>= 1) ss += __shfl_xor(ss, o);
      const float rs = rsqrtf(ss * (1.0f / 1024.0f) + 1e-6f);
#pragma unroll
      for (int q = 0; q < 4; ++q) {
        if constexpr (FP8OUT) {
          *reinterpret_cast<unsigned int*>(out8 + (size_t)(row0 + r) * 1024 + q * 256 + lane * 4) =
              pack4_fp8_ns(v[r][q].x * rs * gg[q].x, v[r][q].y * rs * gg[q].y, v[r][q].z * rs * gg[q].z, v[r][q].w * rs * gg[q].w);
          if (out16) {
            uint2 o2; o2.x = pack2(v[r][q].x * rs * gg[q].x, v[r][q].y * rs * gg[q].y); o2.y = pack2(v[r][q].z * rs * gg[q].z, v[r][q].w * rs * gg[q].w);
            *reinterpret_cast<uint2*>(out16 + (size_t)(row0 + r) * 1024 + q * 256 + lane * 4) = o2;
          }
        } else {
          uint2 o2; o2.x = pack2(v[r][q].x * rs * gg[q].x, v[r][q].y * rs * gg[q].y); o2.y = pack2(v[r][q].z * rs * gg[q].z, v[r][q].w * rs * gg[q].w);
          *reinterpret_cast<uint2*>(out + (size_t)(row0 + r) * 1024 + q * 256 + lane * 4) = o2;
        }
      }
    }
  }
}

__device__ __forceinline__ void s5_tables(const MP& p, int tid);
__device__ __forceinline__ void rope_table(const MP& p, int tid);
__device__ __forceinline__ void phase_prep_mix(const MP& p0) {
  const MP p = kparams_load(); (void)p0;
  const int tid0 = opaque_tid();
  const int n0 = 128, n1 = n0 + 256, n2 = n1 + 128, n3 = n2 + 128, n4 = n3 + 256, n5 = n4 + 256;
  for (int t = blockIdx.x; t < n5; t += gridDim.x) {
    const float* src; u16* dst; int ldsrc, K, mode, r, kts;
    if (t < n0) continue;
    else if (t < n1) { src = p.in[12]; dst = (u16*)(p.ws + WS_WT_GLU); ldsrc = 2048; K = 512; mode = MAP_GLU; r = t - n0; kts = 8; }
    else if (t < n3) continue;
    else if (t < n4) { src = p.in[21]; dst = (u16*)(p.ws + WS_WT_OUT); ldsrc = 1024; K = 1024; mode = MAP_PERM; r = t - n3; kts = 16; }
    else continue;
    const int kt = r % kts, ntile = r / kts;
    transpose_tile(src, ldsrc, dst, K, kt * 64, ntile * 64, mode, tid0);
  }
  rms_rows<true>(p.in[0], p.in[2], p.ws + WS_H, TTOK, tid0);
  rms_rows<true>(p.in[1], p.in[16], p.ws + WS_MEMN, 512, tid0);
  s5_tables(p, tid0);
  rope_table(p, tid0);
  for (int i = blockIdx.x * NTHR + tid0; i < 1024 + 16; i += gridDim.x * NTHR) reinterpret_cast<int*>(p.ws + WS_MCNT)[i] = 0;
}

struct PolGemm1 {
  static constexpr bool FP8 = true, HALFN = false;
  static constexpr int EPI_VM = 16;
  struct Unit { int pm, pn; };
  typedef OpLin OA; typedef OpLin OB;
  int tid;
  __device__ __forceinline__ int nt() const { return 8; }
  __device__ __forceinline__ bool unit(int i, Unit& u) const {
    const int L = i * gridDim.x + blockIdx.x;
    if (L >= 128 * 20) return false;
    unit_order(L, 128, 20, u.pm, u.pn); if (u.pn >= 6) u.pn += 2;
    return true;
  }
  __device__ __forceinline__ void ops(const Unit& u, OA& A, OB& B) const {
    const MP p = kparams_load();
    const int tid = opaque_tid();
    A = op_plain(tid, (const u16*)(p.ws + WS_H), (long)u.pm * 256, 512);
    B = op_plain(tid, (const u16*)(p.ws + WS_WT_IN), (long)u.pn * 256, 512);
  }
  __device__ __forceinline__ void epilogue(acc_t& acc, const Unit& u) const {
    const MP p = kparams_load();
    const int te = opaque_tid(), wr = (te >> 8) & 1, wc = (te >> 6) & 3, fr = te & 15, fq = (te >> 4) & 3;
    constexpr float WSI = 1.0f / MOE_WSCALE;
    u16* proj = (u16*)(p.ws + WS_PROJ);
#pragma unroll
    for (int ai = 0; ai < 2; ++ai)
#pragma unroll
      for (int m = 0; m < 4; ++m) {
        const size_t row = (size_t)u.pm * 256 + ai * 128 + wr * 64 + m * 16 + fr;
#pragma unroll
        for (int bj = 0; bj < 2; ++bj) {
          const int col = u.pn * 256 + bj * 128 + wc * 32 + fq * 8;
          if (u.pn < 2) {
            uint4 o;
            o.x = pack2(WSI * acc[ai][bj][m][0][0], WSI * acc[ai][bj][m][0][1]); o.y = pack2(WSI * acc[ai][bj][m][0][2], WSI * acc[ai][bj][m][0][3]);
            o.z = pack2(WSI * acc[ai][bj][m][1][0], WSI * acc[ai][bj][m][1][1]); o.w = pack2(WSI * acc[ai][bj][m][1][2], WSI * acc[ai][bj][m][1][3]);
            *reinterpret_cast<uint4*>(reinterpret_cast<u16*>(p.ws + WS_UC) + ((size_t)(col >> 4) * TTOK + row) * 16 + (col & 15)) = o;
          } else if (u.pn >= 10) {
            uint2 o;
            o.x = pack4_fp8_ns(WSI * acc[ai][bj][m][0][0], WSI * acc[ai][bj][m][0][1], WSI * acc[ai][bj][m][0][2], WSI * acc[ai][bj][m][0][3]);
            o.y = pack4_fp8_ns(WSI * acc[ai][bj][m][1][0], WSI * acc[ai][bj][m][1][1], WSI * acc[ai][bj][m][1][2], WSI * acc[ai][bj][m][1][3]);
            *reinterpret_cast<uint2*>(reinterpret_cast<unsigned char*>(proj) + row * 11264 + GATE8_OFF + (col - 2560)) = o;
          } else {
            uint4 o;
            o.x = pack2(WSI * acc[ai][bj][m][0][0], WSI * acc[ai][bj][m][0][1]); o.y = pack2(WSI * acc[ai][bj][m][0][2], WSI * acc[ai][bj][m][0][3]);
            o.z = pack2(WSI * acc[ai][bj][m][1][0], WSI * acc[ai][bj][m][1][1]); o.w = pack2(WSI * acc[ai][bj][m][1][2], WSI * acc[ai][bj][m][1][3]);
            *reinterpret_cast<uint4*>(proj + row * 5632 + col) = o;
          }
        }
      }
  }
};
struct PolGemm1U {
  static constexpr bool FP8 = false, HALFN = false;
  static constexpr int EPI_VM = 16;
  struct Unit { int pm, pn; };
  typedef OpLin OA; typedef OpLin OB;
  int tid;
  __device__ __forceinline__ int nt() const { return 16; }
  __device__ __forceinline__ bool unit(int i, Unit& u) const {
    const int L = i * gridDim.x + blockIdx.x;
    if (L >= 128 * 2) return false;
    u.pm = L >> 1; u.pn = L & 1;
    return true;
  }
  __device__ __forceinline__ void ops(const Unit& u, OA& A, OB& B) const {
    const MP p = kparams_load();
    const int tid = opaque_tid();
    A = op_plain(tid, (const u16*)(p.ws + WS_H16), (long)u.pm * 256, 1024);
    B = op_plain(tid, (const u16*)(p.ws + WS_WT_IN16), (long)u.pn * 256, 1024);
  }
  __device__ __forceinline__ void epilogue(acc_t& acc, const Unit& u) const {
    const MP p = kparams_load();
    const int te = opaque_tid(), wr = (te >> 8) & 1, wc = (te >> 6) & 3, fr = te & 15, fq = (te >> 4) & 3;
    constexpr float WSI = 1.0f;
    u16* proj = (u16*)(p.ws + WS_PROJ);
#pragma unroll
    for (int ai = 0; ai < 2; ++ai)
#pragma unroll
      for (int m = 0; m < 4; ++m) {
        const size_t row = (size_t)u.pm * 256 + ai * 128 + wr * 64 + m * 16 + fr;
#pragma unroll
        for (int bj = 0; bj < 2; ++bj) {
          const int col = u.pn * 256 + bj * 128 + wc * 32 + fq * 8;
          uint4 o;
          o.x = pack2(WSI * acc[ai][bj][m][0][0], WSI * acc[ai][bj][m][0][1]); o.y = pack2(WSI * acc[ai][bj][m][0][2], WSI * acc[ai][bj][m][0][3]);
          o.z = pack2(WSI * acc[ai][bj][m][1][0], WSI * acc[ai][bj][m][1][1]); o.w = pack2(WSI * acc[ai][bj][m][1][2], WSI * acc[ai][bj][m][1][3]);
          *reinterpret_cast<uint4*>(proj + row * 5632 + col) = o;
        }
      }
  }
};
struct PolVT {
  static constexpr bool FP8 = true, HALFN = false;
  static constexpr int EPI_VM = 16;
  struct Unit { int pm, pn; };
  typedef OpLin OA; typedef OpLin OB;
  int tid;
  __device__ __forceinline__ int nt() const { return 8; }
  __device__ __forceinline__ bool unit(int i, Unit& u) const {
    const int L = i * gridDim.x + blockIdx.x;
    if (L >= 256) return false;
    u.pm = L & 1; u.pn = L >> 1;
    return true;
  }
  __device__ __forceinline__ void ops(const Unit& u, OA& A, OB& B) const {
    const MP p = kparams_load();
    const int tid = opaque_tid();
    A = op_plain(tid, (const u16*)(p.ws + WS_WT_IN), (long)1536 + u.pm * 256, 512);
    B = op_plain(tid, (const u16*)(p.ws + WS_H), (long)u.pn * 256, 512, true);
  }
  __device__ __forceinline__ void epilogue(acc_t& acc, const Unit& u) const {
    const MP p = kparams_load();
    const int te = opaque_tid(), wr = (te >> 8) & 1, wc = (te >> 6) & 3, fr = te & 15, fq = (te >> 4) & 3;
    constexpr float WSI = 1.0f / MOE_WSCALE;
    u16* vt = (u16*)(p.ws + WS_VT);
    const int tok0 = u.pn * 256, bb = tok0 / SEQ, l0 = tok0 % SEQ;
#pragma unroll
    for (int ai = 0; ai < 2; ++ai)
#pragma unroll
      for (int m = 0; m < 4; ++m) {
        const int dslot = u.pm * 256 + ai * 128 + wr * 64 + m * 16 + fr;
        const int dg = (dslot & ~31) + perm32(dslot & 31);
        u16* vrow = vt + ((size_t)bb * 512 + dg) * SEQ + l0;
#pragma unroll
        for (int bj = 0; bj < 2; ++bj) {
          const int col = bj * 128 + wc * 32 + fq * 8;
          uint4 o;
          o.x = pack2(WSI * acc[ai][bj][m][0][0], WSI * acc[ai][bj][m][0][1]); o.y = pack2(WSI * acc[ai][bj][m][0][2], WSI * acc[ai][bj][m][0][3]);
          o.z = pack2(WSI * acc[ai][bj][m][1][0], WSI * acc[ai][bj][m][1][1]); o.w = pack2(WSI * acc[ai][bj][m][1][2], WSI * acc[ai][bj][m][1][3]);
          *reinterpret_cast<uint4*>(vrow + col) = o;
        }
      }
  }
};
struct PolKV {
  static constexpr bool FP8 = true, HALFN = false;
  static constexpr int EPI_VM = 16;
  struct Unit { int vt, pm, pn; };
  typedef OpLin OA; typedef OpLin OB;
  int tid;
  __device__ __forceinline__ int nt() const { return 8; }
  __device__ __forceinline__ bool unit(int i, Unit& u) const {
    const int L = (int)blockIdx.x - 128;
    if (i > 0 || L < 0 || L >= 8) return false;
    u.vt = L >> 2; u.pm = L & 1; u.pn = (L >> 1) & 1;
    return true;
  }
  __device__ __forceinline__ void ops(const Unit& u, OA& A, OB& B) const {
    const MP p = kparams_load();
    if (u.vt) {
      A = op_plain(tid, (const u16*)(p.ws + WS_WT_KV), (long)512 + u.pm * 256, 512);
      B = op_plain(tid, (const u16*)(p.ws + WS_MEMN), (long)u.pn * 256, 512, true);
    } else {
      A = op_plain(tid, (const u16*)(p.ws + WS_MEMN), (long)u.pm * 256, 512);
      B = op_plain(tid, (const u16*)(p.ws + WS_WT_KV), (long)u.pn * 256, 512);
    }
  }
  __device__ __forceinline__ void epilogue(acc_t& acc, const Unit& u) const {
    const MP p = kparams_load();
    const int te = opaque_tid(), wr = (te >> 8) & 1, wc = (te >> 6) & 3, fr = te & 15, fq = (te >> 4) & 3;
    constexpr float WSI = 1.0f / MOE_WSCALE;
    float* kraw = (float*)(p.ws + WS_KRAW);
    u16* vmt = (u16*)(p.ws + WS_VMT);
#pragma unroll
    for (int ai = 0; ai < 2; ++ai)
#pragma unroll
      for (int m = 0; m < 4; ++m) {
        const int rslot = u.pm * 256 + ai * 128 + wr * 64 + m * 16 + fr;
        if (u.vt) {
          const int c2 = (rslot & ~31) + perm32(rslot & 31);
          u16* vrow = vmt + (((size_t)u.pn * 4 + (c2 >> 7)) * 128 + (c2 & 127)) * 256;
#pragma unroll
          for (int bj = 0; bj < 2; ++bj) {
            const int key = bj * 128 + wc * 32 + fq * 8;
            uint4 o;
            o.x = pack2(WSI * acc[ai][bj][m][0][0], WSI * acc[ai][bj][m][0][1]); o.y = pack2(WSI * acc[ai][bj][m][0][2], WSI * acc[ai][bj][m][0][3]);
            o.z = pack2(WSI * acc[ai][bj][m][1][0], WSI * acc[ai][bj][m][1][1]); o.w = pack2(WSI * acc[ai][bj][m][1][2], WSI * acc[ai][bj][m][1][3]);
            *reinterpret_cast<uint4*>(vrow + key) = o;
          }
        } else {
#pragma unroll
          for (int bj = 0; bj < 2; ++bj)
#pragma unroll
            for (int n = 0; n < 2; ++n) {
              const int col = u.pn * 256 + bj * 128 + wc * 32 + fq * 8 + n * 4;
              *reinterpret_cast<float4*>(kraw + (size_t)rslot * 512 + col) =
                  make_float4(WSI * acc[ai][bj][m][n][0], WSI * acc[ai][bj][m][n][1], WSI * acc[ai][bj][m][n][2], WSI * acc[ai][bj][m][n][3]);
            }
        }
      }
  }
};
__device__ __forceinline__ void phase_gemm1(const MP& p0) {
  (void)p0;
  { PolGemm1 pol; pol.tid = opaque_tid(); gemm_stream(pol); }
  { PolVT pol; pol.tid = opaque_tid(); gemm_stream(pol); }
}
__device__ __forceinline__ void phase_kvgemm(const MP& p0) {
  (void)p0;
  { PolKV pol; pol.tid = opaque_tid(); gemm_stream(pol); }
}

__device__ __forceinline__ void s5_tables(const MP& p, int tid) {
  extern __shared__ __attribute__((aligned(16))) unsigned char lds_raw[];
  const int wid = tid >> 6, lane = tid & 63;
  float* wl = reinterpret_cast<float*>(lds_raw) + wid * 4224;
  float* apr = wl;
  float* api = apr + 64;
  float* wr_ = api + 64;
  float* wi_ = wr_ + 1024;
  float* cre_l = wi_ + 1024;
  float* cim_l = cre_l + 1024;
  const float* lam_re = p.in[4]; const float* lam_im = p.in[5]; const float* log_dt = p.in[6];
  const float* b_re = p.in[7]; const float* b_im = p.in[8]; const float* c_re = p.in[9]; const float* c_im = p.in[10];
  u16* KT = (u16*)(p.ws + WS_KT); u16* FT = (u16*)(p.ws + WS_FT); u16* ET = (u16*)(p.ws + WS_ET);
  float* A64 = (float*)(p.ws + WS_A64);
  __syncthreads();
  for (int task = blockIdx.x * 8 + wid; task < 32 * 65; task += gridDim.x * 8) {
    const int g = task / 65, dl = task % 65;
    float pr = 1.f, pi = 0.f, crl, cil;
    {
      const int i = g * 64 + lane;
      const float dt = expf(log_dt[g]);
      const float lr = lam_re[i], li = lam_im[i];
      const float mag = expf(lr * dt);
      float sn, cs; sincos_acc(li * dt, sn, cs);
      const float a_r = mag * cs, a_i = mag * sn;
      const float nr = a_r - 1.0f, den = lr * lr + li * li;
      crl = (nr * lr + a_i * li) / den;
      cil = (a_i * lr - nr * li) / den;
      for (int k = 0; k < dl; ++k) { float nr2 = pr * a_r - pi * a_i; pi = pr * a_i + pi * a_r; pr = nr2; }
    }
    asm volatile("s_waitcnt lgkmcnt(0)" ::: "memory");
    apr[lane] = pr; api[lane] = pi;
#pragma unroll
    for (int q = 0; q < 4; ++q) {
      const float4 br = *reinterpret_cast<const float4*>(b_re + (size_t)g * 1024 + lane * 16 + q * 4);
      const float4 bi = *reinterpret_cast<const float4*>(b_im + (size_t)g * 1024 + lane * 16 + q * 4);
      const float brv[4] = {br.x, br.y, br.z, br.w}, biv[4] = {bi.x, bi.y, bi.z, bi.w};
      float4 owr, owi; float* owrp = &owr.x; float* owip = &owi.x;
#pragma unroll
      for (int j = 0; j < 4; ++j) {
        const float bbr = crl * brv[j] - cil * biv[j], bbi = crl * biv[j] + cil * brv[j];
        owrp[j] = pr * bbr - pi * bbi;
        owip[j] = pr * bbi + pi * bbr;
      }
      *reinterpret_cast<float4*>(wr_ + lane * 16 + q * 4) = owr;
      *reinterpret_cast<float4*>(wi_ + lane * 16 + q * 4) = owi;
      *reinterpret_cast<float4*>(cre_l + q * 256 + lane * 4) = *reinterpret_cast<const float4*>(c_re + (size_t)g * 1024 + q * 256 + lane * 4);
      *reinterpret_cast<float4*>(cim_l + q * 256 + lane * 4) = *reinterpret_cast<const float4*>(c_im + (size_t)g * 1024 + q * 256 + lane * 4);
    }
    asm volatile("s_waitcnt lgkmcnt(0)" ::: "memory");
    __builtin_amdgcn_wave_barrier();
    if (dl <= 63) {
#pragma unroll
      for (int j = 0; j < 4; ++j) {
        const int o = lane + 64 * j, ho = o >> 4, hi = o & 15;
        float acc = 0.f;
#pragma unroll 8
        for (int pp = 0; pp < 64; ++pp) acc += cre_l[ho * 64 + pp] * wr_[pp * 16 + hi] - cim_l[ho * 64 + pp] * wi_[pp * 16 + hi];
        KT[((size_t)g * 127 + dl + 63) * 256 + o] = f2bf(acc);
        if (dl <= 62) KT[((size_t)g * 127 + 62 - dl) * 256 + o] = 0;
      }
      const int tau = 63 - dl;
#pragma unroll
      for (int c = 0; c < 2; ++c) {
        const float* wsrc = (c ? wi_ : wr_) + lane * 16;
        float f[16];
#pragma unroll
        for (int q = 0; q < 4; ++q) { const float4 v = *reinterpret_cast<const float4*>(wsrc + q * 4); f[q * 4] = v.x; f[q * 4 + 1] = v.y; f[q * 4 + 2] = v.z; f[q * 4 + 3] = v.w; }
        u16* dst = FT + ((size_t)g * 128 + c * 64 + lane) * 1024 + tau * 16;
        uint4 o0, o1;
        o0.x = pack2(f[0], f[1]); o0.y = pack2(f[2], f[3]); o0.z = pack2(f[4], f[5]); o0.w = pack2(f[6], f[7]);
        o1.x = pack2(f[8], f[9]); o1.y = pack2(f[10], f[11]); o1.z = pack2(f[12], f[13]); o1.w = pack2(f[14], f[15]);
        *reinterpret_cast<uint4*>(dst) = o0; *reinterpret_cast<uint4*>(dst + 8) = o1;
      }
    }
    if (dl >= 1) {
      const int t = dl - 1;
#pragma unroll 4
      for (int ho = 0; ho < 16; ++ho) {
        float v2[2];
#pragma unroll
        for (int h = 0; h < 2; ++h) {
          const int k = 2 * lane + h, c = k >> 6, pp = k & 63;
          const float cre = cre_l[ho * 64 + pp], cim = cim_l[ho * 64 + pp];
          v2[h] = c ? -(cre * api[pp] + cim * apr[pp]) : (cre * apr[pp] - cim * api[pp]);
        }
        *reinterpret_cast<unsigned int*>(ET + ((size_t)g * 1024 + t * 16 + ho) * 128 + 2 * lane) = pack2(v2[0], v2[1]);
      }
    }
    if (dl == 64) { A64[(g * 64 + lane) * 2] = pr; A64[(g * 64 + lane) * 2 + 1] = pi; }
  }
  __syncthreads();
}

__device__ __forceinline__ OpLin op_u(int tid, const u16* uc, int g, int pm) {
  return op_plain(tid, uc + (size_t)g * TTOK * 16, (long)pm * 256, 1024);
}

struct PolS5S {
  static constexpr bool FP8 = false, HALFN = true;
  static constexpr int EPI_VM = 16;
  struct Unit { int g, pm, kh; };
  typedef OpLin OA; typedef OpLin OB;
  int tid;
  __device__ __forceinline__ int nt() const { return 8; }
  __device__ __forceinline__ bool unit(int i, Unit& u) const {
    const int L = i * gridDim.x + blockIdx.x;
    if (L >= 128) return false;
    u.g = L >> 2; u.pm = (L >> 1) & 1; u.kh = L & 1; return true;
  }
  __device__ __forceinline__ void ops(const Unit& u, OA& A, OB& B) const {
    const MP p = kparams_load();
    A = op_u(tid, (const u16*)(p.ws + WS_UC), u.g, u.pm);
    B = op_plain(tid, (const u16*)(p.ws + WS_FT) + (size_t)u.g * 128 * 1024, 0, 1024);
    A.base += u.kh * 8 * A.kstep; B.base += u.kh * 8 * B.kstep;
  }
  __device__ __forceinline__ void epilogue(acc_t& acc, const Unit& u) const {
    const MP p = kparams_load();
    const int te = opaque_tid(), wr = (te >> 8) & 1, wc = (te >> 6) & 3, fr = te & 15, fq = (te >> 4) & 3;
    float* S = (float*)(p.ws + WS_S5S) + (size_t)u.kh * 512 * 32 * 128;
#pragma unroll
    for (int ai = 0; ai < 2; ++ai)
#pragma unroll
      for (int m = 0; m < 4; ++m) {
        const size_t chunk = (size_t)u.pm * 256 + ai * 128 + wr * 64 + m * 16 + fr;
#pragma unroll
        for (int n = 0; n < 2; ++n) {
          const int col = wc * 32 + n * 16 + fq * 4;
          float4 o = make_float4(acc[ai][0][m][n][0], acc[ai][0][m][n][1], acc[ai][0][m][n][2], acc[ai][0][m][n][3]);
          *reinterpret_cast<float4*>(S + (chunk * 32 + u.g) * 128 + col) = o;
        }
      }
  }
};
__device__ __forceinline__ void phase_s5s(const MP& p0) {
  (void)p0;
  PolS5S pol; pol.tid = opaque_tid();
  gemm_stream(pol);
}

__device__ __forceinline__ void phase_s5scan(const MP& p0) {
  const MP p = kparams_load(); (void)p0;
  const int tid = opaque_tid();
  if (blockIdx.x >= 8) return;
  const int id = blockIdx.x * NTHR + tid, pp = id & 63, g = (id >> 6) & 31, b = id >> 11;
  const float* S = (const float*)(p.ws + WS_S5S);
  u16* CR = (u16*)(p.ws + WS_CARRY);
  const float* A64 = (const float*)(p.ws + WS_A64);
  const float ar = A64[(g * 64 + pp) * 2], ai = A64[(g * 64 + pp) * 2 + 1];
  float cr = 0.f, ci = 0.f;
  for (int c0 = 0; c0 < 256; c0 += 8) {
    float sr[8], si[8];
#pragma unroll
    for (int j = 0; j < 8; ++j) {
      const size_t base = (((size_t)b * 256 + c0 + j) * 32 + g) * 128;
      sr[j] = S[base + pp] + S[base + pp + (size_t)512 * 32 * 128]; si[j] = S[base + 64 + pp] + S[base + 64 + pp + (size_t)512 * 32 * 128];
    }
#pragma unroll
    for (int j = 0; j < 8; ++j) {
      const size_t base = (((size_t)b * 256 + c0 + j) * 32 + g) * 128;
      CR[base + pp] = f2bf(cr); CR[base + 64 + pp] = f2bf(ci);
      const float nr = ar * cr - ai * ci + sr[j];
      ci = ar * ci + ai * cr + si[j];
      cr = nr;
    }
  }
}

__device__ __forceinline__ void phase_s5y(const MP& p0) {
  const MP p = kparams_load(); (void)p0;
  for (int unit = blockIdx.x; unit < 256; unit += gridDim.x) {
    const int tid = opaque_tid();
    const int g = unit >> 3, pm = (unit >> 2) & 1, pn = unit & 3;
    acc_t acc;
    acc_zero(acc);
    {
      OpLin A = op_u(tid, (const u16*)(p.ws + WS_UC), g, pm);
      OpLin B;
      B.base = reinterpret_cast<const char*>((const u16*)(p.ws + WS_KT) + (size_t)g * 127 * 256) + ((pn * 16 + 63) * 256) * 2 - 3 * 512;
#pragma unroll
      for (int i = 0; i < 2; ++i) { int R, C; stage_rc(tid * 16 + i * 8192, R, C); B.voff[i] = (unsigned)(((R >> 4) * 256 + (R & 15) * 16) * 2 + (3 - (C >> 4)) * 512 + (C & 15) * 2); }
      B.hstep = 4096; B.kstep = -2048;
      gemm_unit<false>(tid, acc, A, B, 4 * (pn + 1));
    }
#ifndef S5Y_NOSEG2
    {
      const int tid2 = opaque_tid();
      OpLin A;
      A.base = reinterpret_cast<const char*>((const u16*)(p.ws + WS_CARRY) + ((size_t)pm * 256 * 32 + g) * 128);
#pragma unroll
      for (int i = 0; i < 2; ++i) { int R, C; stage_rc(tid2 * 16 + i * 8192, R, C); A.voff[i] = (unsigned)((R * 32 * 128 + C) * 2); }
      A.hstep = (long)128 * 32 * 128 * 2; A.kstep = 128;
      OpLin B = op_plain(tid2, (const u16*)(p.ws + WS_ET) + (size_t)g * 1024 * 128, (long)pn * 256, 128);
      gemm_unit<false>(tid2, acc, A, B, 2);
    }
#endif
    const int te = opaque_tid(), wr = (te >> 8) & 1, wc = (te >> 6) & 3, fr = te & 15, fq = (te >> 4) & 3;
    const u16* proj = (const u16*)(p.ws + WS_PROJ);
    u16* yg = (u16*)(p.ws + WS_YGELU);
    const float4 dsk = *reinterpret_cast<const float4*>(p.in[11] + g * 16 + fq * 4);
#pragma unroll
    for (int ai = 0; ai < 2; ++ai) {
      uint2 uq[4][2][2];
#pragma unroll
      for (int m = 0; m < 4; ++m) {
        const size_t chunk = (size_t)pm * 256 + ai * 128 + wr * 64 + m * 16 + fr;
#pragma unroll
        for (int bj = 0; bj < 2; ++bj)
#pragma unroll
          for (int n = 0; n < 2; ++n) {
            const size_t tok = chunk * 64 + pn * 16 + bj * 8 + wc * 2 + n;
            uq[m][bj][n] = *reinterpret_cast<const uint2*>(reinterpret_cast<const u16*>(p.ws + WS_UC) + ((size_t)g * TTOK + tok) * 16 + fq * 4);
          }
      }
#pragma unroll
      for (int m = 0; m < 4; ++m) {
        const size_t chunk = (size_t)pm * 256 + ai * 128 + wr * 64 + m * 16 + fr;
#pragma unroll
        for (int bj = 0; bj < 2; ++bj)
#pragma unroll
          for (int n = 0; n < 2; ++n) {
            const size_t tok = chunk * 64 + pn * 16 + bj * 8 + wc * 2 + n;
            const uint2 uu = uq[m][bj][n];
            float y[4];
            y[0] = acc[ai][bj][m][n][0] + dsk.x * __uint_as_float(uu.x << 16);
            y[1] = acc[ai][bj][m][n][1] + dsk.y * __uint_as_float(uu.x & 0xffff0000u);
            y[2] = acc[ai][bj][m][n][2] + dsk.z * __uint_as_float(uu.y << 16);
            y[3] = acc[ai][bj][m][n][3] + dsk.w * __uint_as_float(uu.y & 0xffff0000u);
#pragma unroll
            for (int j = 0; j < 4; ++j) {
              const float v = y[j];
              const float inner = 0.7978845608028654f * (v + 0.044715f * v * v * v);
              const float th = 1.0f - 2.0f * __builtin_amdgcn_rcpf(__builtin_amdgcn_exp2f(2.0f * 1.4426950408889634f * inner) + 1.0f);
              y[j] = 0.5f * v * (1.0f + th);
            }
            uint2 o; o.x = pack2(y[0], y[1]); o.y = pack2(y[2], y[3]);
            *reinterpret_cast<uint2*>(yg + tok * 512 + g * 16 + fq * 4) = o;
          }
      }
      asm volatile("" ::: "memory");
    }
  }
}

__device__ __forceinline__ int queue_next(int* ctr, int tid) {
  extern __shared__ __attribute__((aligned(16))) unsigned char lds_raw[];
  volatile LAS int* slot = (volatile LAS int*)((LAS unsigned char*)lds_raw + LDS_MISC_OFF + 2048 + 64);
  __syncthreads();
  if (tid == 0) *slot = atomicAdd(ctr, 1);
  __syncthreads();
  return *slot;
}

__device__ __forceinline__ void rope_table(const MP& p, int tid) {
  extern __shared__ __attribute__((aligned(16))) unsigned char lds_raw[];
  float* invl = reinterpret_cast<float*>(lds_raw);
  float* rope = (float*)(p.ws + WS_ROPE);
  __syncthreads();
  if (tid < 32) invl[tid] = (float)pow(10000.0, -(double)tid / 32.0);
  __syncthreads();
  for (int i = blockIdx.x * NTHR + tid; i < SEQ * 32; i += gridDim.x * NTHR) {
    const int t = i >> 5, d = i & 31;
    const float inv = invl[d];
    const float ang = (float)t * inv;
    float sn, cs; sincos_acc(ang, sn, cs);
    rope[(size_t)t * 64 + d] = cs;
    rope[(size_t)t * 64 + 32 + d] = sn;
  }
}

__device__ __forceinline__ void head_norm_rope(const u16* __restrict__ src, const float* __restrict__ gg,
                                               const float* __restrict__ rp, float (&v)[64]) {
  float ss = 0.f;
#pragma unroll
  for (int c = 0; c < 8; ++c) {
    float f[8];
    unpack8(*reinterpret_cast<const uint4*>(src + c * 8), f);
#pragma unroll
    for (int j = 0; j < 8; ++j) { v[c * 8 + j] = f[j]; ss += f[j] * f[j]; }
  }
  const float r = rsqrtf(ss * (1.0f / 64.0f) + 1e-6f);
#pragma unroll
  for (int d = 0; d < 64; ++d) v[d] = v[d] * r * gg[d];
#pragma unroll
  for (int d = 0; d < 32; ++d) {
    const float cs = rp[d], sn = rp[32 + d];
    const float x1 = v[d], x2 = v[d + 32];
    v[d] = x1 * cs - x2 * sn;
    v[d + 32] = x2 * cs + x1 * sn;
  }
}
__device__ __forceinline__ void store_row64_bf16(u16* dst, const float (&v)[64]) {
#pragma unroll
  for (int c = 0; c < 8; ++c) {
    float f[8];
#pragma unroll
    for (int j = 0; j < 8; ++j) f[j] = v[c * 8 + j];
    *reinterpret_cast<uint4*>(dst + c * 8) = pack8(f);
  }
}

__device__ __forceinline__ void phase_kprep(const MP& p0) {
  extern __shared__ __attribute__((aligned(16))) unsigned char lds_raw[];
  const MP p = kparams_load(); (void)p0;
  const int tid = opaque_tid();
  float* part = reinterpret_cast<float*>(lds_raw);
  const u16* proj = (const u16*)(p.ws + WS_PROJ);
  const float* rope = (const float*)(p.ws + WS_ROPE);
  u16* knb = (u16*)(p.ws + WS_KN);
  float* kmean = (float*)(p.ws + WS_KMEAN);
  int* qctr = reinterpret_cast<int*>(p.ws + WS_QCTR);
  const int wid = tid >> 6, lane = tid & 63, c = lane & 7, rsub = lane >> 3;
  float gk[8];
#pragma unroll
  for (int j = 0; j < 8; ++j) gk[j] = p.in[14][c * 8 + j];
  for (int task = queue_next(qctr, tid); task < 16 * 32; task = queue_next(qctr, tid)) {
    const int bh = task >> 5, b = bh >> 3, h = bh & 7;
    const int t0 = ((task & 31) * 2) * 256 + wid * 64;
    float msum[8] = {0.f, 0.f, 0.f, 0.f, 0.f, 0.f, 0.f, 0.f};
#pragma unroll 1
    for (int hb = 0; hb < 2; ++hb) {
    uint4 kq[4]; float4 cs4[4][2], sn4[4][2];
#pragma unroll
    for (int st = 0; st < 4; ++st) {
      const int t = t0 + (hb * 4 + st) * 8 + rsub;
      kq[st] = *reinterpret_cast<const uint4*>(proj + ((size_t)b * SEQ + t) * 5632 + 1024 + h * 64 + c * 8);
      const float* rp = rope + (size_t)t * 64 + (c & 3) * 8;
      cs4[st][0] = *reinterpret_cast<const float4*>(rp); cs4[st][1] = *reinterpret_cast<const float4*>(rp + 4);
      sn4[st][0] = *reinterpret_cast<const float4*>(rp + 32); sn4[st][1] = *reinterpret_cast<const float4*>(rp + 36);
    }
#pragma unroll
    for (int st = 0; st < 4; ++st) {
      const int t = t0 + (hb * 4 + st) * 8 + rsub;
      float f[8];
      unpack8(kq[st], f);
      float ss = 0.f;
#pragma unroll
      for (int j = 0; j < 8; ++j) ss += f[j] * f[j];
      ss += __shfl_xor(ss, 1); ss += __shfl_xor(ss, 2); ss += __shfl_xor(ss, 4);
      const float r = rsqrtf(ss * (1.0f / 64.0f) + 1e-6f);
      const float csv[8] = {cs4[st][0].x, cs4[st][0].y, cs4[st][0].z, cs4[st][0].w, cs4[st][1].x, cs4[st][1].y, cs4[st][1].z, cs4[st][1].w};
      const float snv[8] = {sn4[st][0].x, sn4[st][0].y, sn4[st][0].z, sn4[st][0].w, sn4[st][1].x, sn4[st][1].y, sn4[st][1].z, sn4[st][1].w};
      float o[8];
#pragma unroll
      for (int j = 0; j < 8; ++j) {
        const float v = f[j] * r * gk[j];
        const float w = __shfl_xor(v, 4);
        o[j] = (c < 4) ? (v * csv[j] - w * snv[j]) : (v * csv[j] + w * snv[j]);
        msum[j] += o[j];
      }
      *reinterpret_cast<uint4*>(knb + ((size_t)bh * SEQ + t) * 64 + c * 8) = pack8(o);
    }
    }
#pragma unroll
    for (int j = 0; j < 8; ++j) { msum[j] += __shfl_xor(msum[j], 8); msum[j] += __shfl_xor(msum[j], 16); msum[j] += __shfl_xor(msum[j], 32); }
    __syncthreads();
    if (lane < 8) {
#pragma unroll
      for (int j = 0; j < 8; ++j) part[wid * 64 + c * 8 + j] = msum[j];
    }
    __syncthreads();
    if (tid < 128) {
      const int blk = tid >> 6, d = tid & 63;
      const float s = part[(blk * 4 + 0) * 64 + d] + part[(blk * 4 + 1) * 64 + d] + part[(blk * 4 + 2) * 64 + d] + part[(blk * 4 + 3) * 64 + d];
      kmean[((size_t)bh * 64 + (task & 31) * 2 + blk) * 64 + d] = s * (1.0f / 256.0f);
    }
  }
}

__device__ __forceinline__ int mlist_off(int j) { return j * SEQ - 128 * j * (j + 1); }

__device__ __forceinline__ void phase_kmemnorm(const MP& p0) {
  const MP p = kparams_load(); (void)p0;
  const int tid = opaque_tid();
  {
    const float* kraw = (const float*)(p.ws + WS_KRAW);
    const float* g_ck = p.in[19];
    u16* kmn = (u16*)(p.ws + WS_KMEMN);
    for (int i = blockIdx.x * NTHR + tid; i < 512 * 4 * 16; i += gridDim.x * NTHR) {
      const int sub = i & 15, rx = i >> 4, xh = rx & 3, row = rx >> 2;
      const float* src = kraw + (size_t)row * 512 + xh * 128 + sub * 8;
      float4 a = *reinterpret_cast<const float4*>(src), c = *reinterpret_cast<const float4*>(src + 4);
      float ss = a.x * a.x + a.y * a.y + a.z * a.z + a.w * a.w + c.x * c.x + c.y * c.y + c.z * c.z + c.w * c.w;
      ss += __shfl_xor(ss, 1); ss += __shfl_xor(ss, 2); ss += __shfl_xor(ss, 4); ss += __shfl_xor(ss, 8);
      const float r = rsqrtf(ss * (1.0f / 128.0f) + 1e-6f);
      const float* g = g_ck + sub * 8;
      float f[8] = {a.x * r * g[0], a.y * r * g[1], a.z * r * g[2], a.w * r * g[3], c.x * r * g[4], c.y * r * g[5], c.z * r * g[6], c.w * r * g[7]};
      *reinterpret_cast<uint4*>(kmn + (((size_t)(row >> 8) * 4 + xh) * 256 + (row & 255)) * 128 + sub * 8) = pack8(f);
    }
  }
}

__device__ __forceinline__ void phase_gate(const MP& p0, int rep = 0) {
  extern __shared__ __attribute__((aligned(16))) unsigned char lds_raw[];
  const MP p = kparams_load(); (void)p0;
  const int tid = opaque_tid();
  float* km = reinterpret_cast<float*>(lds_raw);
  int* hist = reinterpret_cast<int*>(km + 4096);
  int* gbase = hist + 64;
  const u16* proj = (const u16*)(p.ws + WS_PROJ);
  const float* rope = (const float*)(p.ws + WS_ROPE);
  u16* qnb = (u16*)(p.ws + WS_QN);
  const float* kmean = (const float*)(p.ws + WS_KMEAN);
  int* mcnt = (int*)(p.ws + WS_MCNT);
  int* mlist = (int*)(p.ws + WS_MLIST);
  int* qctr = reinterpret_cast<int*>(p.ws + WS_QCTR) + 1;
  for (int task = queue_next(qctr, tid); task < 16 * 32; task = queue_next(qctr, tid)) {
    const int bh = task & 15, c512 = 31 - (task >> 4), b = bh >> 3, h = bh & 7;
    const int t = c512 * 512 + tid, qblk = t >> 8;
    const int nblk = c512 * 2 + 1;
    __syncthreads();
    for (int i = tid; i < nblk * 64; i += NTHR) km[i] = kmean[(size_t)bh * 4096 + i];
    if (tid < 64) hist[tid] = 0;
    __syncthreads();
    float q[64];
    head_norm_rope(proj + ((size_t)b * SEQ + t) * 5632 + 512 + h * 64, p.in[13], rope + (size_t)t * 64, q);
    {
      float qs[64];
#pragma unroll
      for (int d = 0; d < 64; ++d) qs[d] = q[d] * (0.125f * 1.4426950408889634f);
      store_row64_bf16(qnb + ((size_t)bh * SEQ + t) * 64, qs);
    }
    float tv0 = -INFINITY, tv1 = -INFINITY, tv2 = -INFINITY;
    int ti0 = -1, ti1 = -1, ti2 = -1;
    for (int j = 0; j < qblk; ++j) {
      const float* kj = km + j * 64;
      float sacc = 0.f;
#pragma unroll
      for (int d = 0; d < 64; ++d) sacc = fmaf(q[d], kj[d], sacc);
      if (sacc > tv0) { tv2 = tv1; ti2 = ti1; tv1 = tv0; ti1 = ti0; tv0 = sacc; ti0 = j; }
      else if (sacc > tv1) { tv2 = tv1; ti2 = ti1; tv1 = sacc; ti1 = j; }
      else if (sacc > tv2) { tv2 = sacc; ti2 = j; }
    }
    if (rep) { ti0 = ti1 = ti2 = -1; }
    int lp0 = 0, lp1 = 0, lp2 = 0;
    if (ti0 >= 0) lp0 = atomicAdd(&hist[ti0], 1);
    if (ti1 >= 0) lp1 = atomicAdd(&hist[ti1], 1);
    if (ti2 >= 0) lp2 = atomicAdd(&hist[ti2], 1);
    __syncthreads();
    if (tid < 64) gbase[tid] = hist[tid] ? atomicAdd(&mcnt[bh * 64 + tid], hist[tid]) : 0;
    __syncthreads();
    int* lb = mlist + (size_t)bh * 516096;
    if (ti0 >= 0) lb[mlist_off(ti0) + gbase[ti0] + lp0] = t * 4 + 0;
    if (ti1 >= 0) lb[mlist_off(ti1) + gbase[ti1] + lp1] = t * 4 + 1;
    if (ti2 >= 0) lb[mlist_off(ti2) + gbase[ti2] + lp2] = t * 4 + 2;
  }
}

template <int DH, int NK>
__device__ __forceinline__ void attn_wave(LAS const unsigned char* ldsK, LAS const unsigned char* ldsVT,
                                          const bf16x8 (&qf)[DH / 32], int npairs, int causal_qpos, float c1, float c2,
                                          f32x4 (&o)[DH / 16], float& lsum, int fr, int fq) {
  constexpr int KROW = (DH + 8) * 2, VROW = (NK + 8) * 2;
  auto pair = [&](int i) {
    {
      f32x4 s0 = {0.f, 0.f, 0.f, 0.f}, s1 = {0.f, 0.f, 0.f, 0.f};
#pragma unroll
      for (int ks = 0; ks < DH / 32; ++ks) {
        const bf16x8 k0 = *(const LAS bf16x8*)(ldsK + ((2 * i) * 16 + fr) * KROW + (ks * 32 + fq * 8) * 2);
        const bf16x8 k1 = *(const LAS bf16x8*)(ldsK + ((2 * i + 1) * 16 + fr) * KROW + (ks * 32 + fq * 8) * 2);
        s0 = __builtin_amdgcn_mfma_f32_16x16x32_bf16(k0, qf[ks], s0, 0, 0, 0);
        s1 = __builtin_amdgcn_mfma_f32_16x16x32_bf16(k1, qf[ks], s1, 0, 0, 0);
      }
      float pv[8];
#pragma unroll
      for (int r = 0; r < 4; ++r) {
        pv[r] = __builtin_amdgcn_exp2f(fmaf(s0[r], c1, -c2));
        pv[4 + r] = __builtin_amdgcn_exp2f(fmaf(s1[r], c1, -c2));
      }
      if (causal_qpos >= 0) {
#pragma unroll
        for (int r = 0; r < 4; ++r) {
          if (32 * i + 4 * fq + r > causal_qpos) pv[r] = 0.f;
          if (32 * i + 16 + 4 * fq + r > causal_qpos) pv[4 + r] = 0.f;
        }
      }
#pragma unroll
      for (int r = 0; r < 8; ++r) lsum += pv[r];
      union { bf16x8 v; unsigned int u[4]; } pf;
      pf.u[0] = pack2(pv[0], pv[1]); pf.u[1] = pack2(pv[2], pv[3]); pf.u[2] = pack2(pv[4], pv[5]); pf.u[3] = pack2(pv[6], pv[7]);
#pragma unroll
      for (int ds = 0; ds < DH / 16; ++ds) {
        union { bf16x8 v; u32x2 h[2]; } vf;
        vf.h[0] = *(const LAS u32x2*)(ldsVT + (ds * 16 + fr) * VROW + (32 * i + 4 * fq) * 2);
        vf.h[1] = *(const LAS u32x2*)(ldsVT + (ds * 16 + fr) * VROW + (32 * i + 16 + 4 * fq) * 2);
        o[ds] = __builtin_amdgcn_mfma_f32_16x16x32_bf16(vf.v, pf.v, o[ds], 0, 0, 0);
      }
    }
  };
  if constexpr (DH == 64) {
#pragma unroll 1
    for (int i = 0; i < NK / 32; i += 2) {
      if (i < npairs) pair(i);
      if (i + 1 < npairs) pair(i + 1);
    }
  } else {
#pragma unroll 1
    for (int i = 0; i < NK / 32; ++i)
      if (i < npairs) pair(i);
  }
}

template <int DH, int NK>
__device__ __forceinline__ void attn_wave2(LAS const unsigned char* ldsK, LAS const unsigned char* ldsVT,
                                           const bf16x8 (&qa)[DH / 32], const bf16x8 (&qb)[DH / 32], int npairs, int causal, int cqa, int cqb,
                                           float c1, float c2, f32x4 (&oa)[DH / 16], f32x4 (&ob)[DH / 16], float& lsa, float& lsb, int fr, int fq) {
  constexpr int KROW = (DH + 8) * 2, VROW = (NK + 8) * 2;
#pragma unroll 1
  for (int i = 0; i < npairs; ++i) {
    f32x4 a0 = {0.f, 0.f, 0.f, 0.f}, a1 = {0.f, 0.f, 0.f, 0.f}, b0 = {0.f, 0.f, 0.f, 0.f}, b1 = {0.f, 0.f, 0.f, 0.f};
#pragma unroll
    for (int ks = 0; ks < DH / 32; ++ks) {
      const bf16x8 k0 = *(const LAS bf16x8*)(ldsK + ((2 * i) * 16 + fr) * KROW + (ks * 32 + fq * 8) * 2);
      const bf16x8 k1 = *(const LAS bf16x8*)(ldsK + ((2 * i + 1) * 16 + fr) * KROW + (ks * 32 + fq * 8) * 2);
      a0 = __builtin_amdgcn_mfma_f32_16x16x32_bf16(k0, qa[ks], a0, 0, 0, 0);
      a1 = __builtin_amdgcn_mfma_f32_16x16x32_bf16(k1, qa[ks], a1, 0, 0, 0);
      b0 = __builtin_amdgcn_mfma_f32_16x16x32_bf16(k0, qb[ks], b0, 0, 0, 0);
      b1 = __builtin_amdgcn_mfma_f32_16x16x32_bf16(k1, qb[ks], b1, 0, 0, 0);
    }
    float pa[8], pb[8];
#pragma unroll
    for (int r = 0; r < 4; ++r) {
      pa[r] = __builtin_amdgcn_exp2f(fmaf(a0[r], c1, -c2));
      pa[4 + r] = __builtin_amdgcn_exp2f(fmaf(a1[r], c1, -c2));
      pb[r] = __builtin_amdgcn_exp2f(fmaf(b0[r], c1, -c2));
      pb[4 + r] = __builtin_amdgcn_exp2f(fmaf(b1[r], c1, -c2));
    }
    if (causal) {
#pragma unroll
      for (int r = 0; r < 4; ++r) {
        const int k0i = 32 * i + 4 * fq + r, k1i = k0i + 16;
        if (k0i > cqa) pa[r] = 0.f;
        if (k1i > cqa) pa[4 + r] = 0.f;
        if (k0i > cqb) pb[r] = 0.f;
        if (k1i > cqb) pb[4 + r] = 0.f;
      }
    }
#pragma unroll
    for (int r = 0; r < 8; ++r) { lsa += pa[r]; lsb += pb[r]; }
    union { bf16x8 v; unsigned int u[4]; } fa, fb;
    fa.u[0] = pack2(pa[0], pa[1]); fa.u[1] = pack2(pa[2], pa[3]); fa.u[2] = pack2(pa[4], pa[5]); fa.u[3] = pack2(pa[6], pa[7]);
    fb.u[0] = pack2(pb[0], pb[1]); fb.u[1] = pack2(pb[2], pb[3]); fb.u[2] = pack2(pb[4], pb[5]); fb.u[3] = pack2(pb[6], pb[7]);
#pragma unroll
    for (int ds = 0; ds < DH / 16; ++ds) {
      union { bf16x8 v; u32x2 h[2]; } vf;
      vf.h[0] = *(const LAS u32x2*)(ldsVT + (ds * 16 + fr) * VROW + (32 * i + 4 * fq) * 2);
      vf.h[1] = *(const LAS u32x2*)(ldsVT + (ds * 16 + fr) * VROW + (32 * i + 16 + 4 * fq) * 2);
      oa[ds] = __builtin_amdgcn_mfma_f32_16x16x32_bf16(vf.v, fa.v, oa[ds], 0, 0, 0);
      ob[ds] = __builtin_amdgcn_mfma_f32_16x16x32_bf16(vf.v, fb.v, ob[ds], 0, 0, 0);
    }
  }
}

template <bool CAUSAL>
__device__ __forceinline__ void attn_wave2p(LAS const unsigned char* ldsK, LAS const unsigned char* ldsVT,
                                            const bf16x8 (&qa)[2], const bf16x8 (&qb)[2], int npairs, int cqa, int cqb,
                                            float c1, float c2, f32x4 (&oa)[4], f32x4 (&ob)[4], float& lsa, float& lsb, int fr, int fq) {
  (void)c1;
  constexpr int KROW = 80 * 2, VROW = 264 * 2;
#define AW_QK(I, S)                                                                                                   \
  {                                                                                                                   \
    S[0] = f32x4{-c2, -c2, -c2, -c2}; S[1] = S[0]; S[2] = S[0]; S[3] = S[0];     \
    _Pragma("unroll") for (int ks = 0; ks < 2; ++ks) {                                                                \
      const bf16x8 k0 = *(const LAS bf16x8*)(ldsK + ((2 * (I)) * 16 + fr) * KROW + (ks * 32 + fq * 8) * 2);           \
      const bf16x8 k1 = *(const LAS bf16x8*)(ldsK + ((2 * (I) + 1) * 16 + fr) * KROW + (ks * 32 + fq * 8) * 2);       \
      S[0] = __builtin_amdgcn_mfma_f32_16x16x32_bf16(k0, qa[ks], S[0], 0, 0, 0);                                      \
      S[1] = __builtin_amdgcn_mfma_f32_16x16x32_bf16(k1, qa[ks], S[1], 0, 0, 0);                                      \
      S[2] = __builtin_amdgcn_mfma_f32_16x16x32_bf16(k0, qb[ks], S[2], 0, 0, 0);                                      \
      S[3] = __builtin_amdgcn_mfma_f32_16x16x32_bf16(k1, qb[ks], S[3], 0, 0, 0);                                      \
    }                                                                                                                 \
  }
#define AW_SM(I, S, FA, FB)                                                                                           \
  {                                                                                                                   \
    float pa[8], pb[8];                                                                                               \
    _Pragma("unroll") for (int r = 0; r < 4; ++r) {                                                                   \
      pa[r] = __builtin_amdgcn_exp2f(S[0][r]);                                                                        \
      pa[4 + r] = __builtin_amdgcn_exp2f(S[1][r]);                                                                    \
      pb[r] = __builtin_amdgcn_exp2f(S[2][r]);                                                                        \
      pb[4 + r] = __builtin_amdgcn_exp2f(S[3][r]);                                                                    \
    }                                                                                                                 \
    if constexpr (CAUSAL) {                                                                                           \
      _Pragma("unroll") for (int r = 0; r < 4; ++r) {                                                                 \
        const int k0i = 32 * (I) + 4 * fq + r, k1i = k0i + 16;                                                        \
        if (k0i > cqa) pa[r] = 0.f;                                                                                   \
        if (k1i > cqa) pa[4 + r] = 0.f;                                                                               \
        if (k0i > cqb) pb[r] = 0.f;                                                                                   \
        if (k1i > cqb) pb[4 + r] = 0.f;                                                                               \
      }                                                                                                               \
    }                                                                                                                 \
    _Pragma("unroll") for (int r = 0; r < 8; ++r) { lsa += pa[r]; lsb += pb[r]; }                                     \
    FA.u[0] = pack2(pa[0], pa[1]); FA.u[1] = pack2(pa[2], pa[3]); FA.u[2] = pack2(pa[4], pa[5]); FA.u[3] = pack2(pa[6], pa[7]); \
    FB.u[0] = pack2(pb[0], pb[1]); FB.u[1] = pack2(pb[2], pb[3]); FB.u[2] = pack2(pb[4], pb[5]); FB.u[3] = pack2(pb[6], pb[7]); \
  }
#define AW_PV(I, FA, FB)                                                                                              \
  {                                                                                                                   \
    _Pragma("unroll") for (int ds = 0; ds < 4; ++ds) {                                                                \
      union { bf16x8 v; u32x2 h[2]; } vf;                                                                             \
      vf.h[0] = *(const LAS u32x2*)(ldsVT + (ds * 16 + fr) * VROW + (32 * (I) + 4 * fq) * 2);                         \
      vf.h[1] = *(const LAS u32x2*)(ldsVT + (ds * 16 + fr) * VROW + (32 * (I) + 16 + 4 * fq) * 2);                    \
      oa[ds] = __builtin_amdgcn_mfma_f32_16x16x32_bf16(vf.v, FA.v, oa[ds], 0, 0, 0);                                  \
      ob[ds] = __builtin_amdgcn_mfma_f32_16x16x32_bf16(vf.v, FB.v, ob[ds], 0, 0, 0);                                  \
    }                                                                                                                 \
  }
#pragma unroll 1
  for (int i = 0; i < npairs; i += 2) {
    f32x4 s0[4], s1[4];
    union { bf16x8 v; unsigned int u[4]; } f0a, f0b, f1a, f1b;
    AW_QK(i, s0)
    AW_QK(i + 1, s1)
    AW_SM(i, s0, f0a, f0b)
    AW_PV(i, f0a, f0b)
    AW_SM(i + 1, s1, f1a, f1b)
    AW_PV(i + 1, f1a, f1b)
  }
#undef AW_QK
#undef AW_SM
#undef AW_PV
}

__device__ __forceinline__ void phase_moba(const MP& p0, int rep = 0) {
  extern __shared__ __attribute__((aligned(16))) unsigned char lds_raw[];
  const MP p = kparams_load(); (void)p0;
  const int tid = opaque_tid();
  LAS unsigned char* lds = (LAS unsigned char*)lds_raw;
  constexpr int K_OFF = 0, VT_OFF = 256 * 160, PFX_OFF = VT_OFF + 64 * 528;
  int* pfx = reinterpret_cast<int*>(lds_raw + PFX_OFF);
  float* misc = reinterpret_cast<float*>(lds_raw + PFX_OFF + 1032 * 4);
  int* lcnt = reinterpret_cast<int*>(lds_raw + PFX_OFF + 1032 * 4 + 256);
  const u16* qn = (const u16*)(p.ws + WS_QN);
  const u16* kn = (const u16*)(p.ws + WS_KN);
  const u16* vt = (const u16*)(p.ws + WS_VT);
  const int* mcnt = (const int*)(p.ws + WS_MCNT);
  const int* mlist = (const int*)(p.ws + WS_MLIST);
  u16* opart = (u16*)p.out;
  float* lpart = (float*)(p.ws + WS_LPART);
  const int wid = tid >> 6, lane = tid & 63, fr = lane & 15, fq = lane >> 4;
  if (tid < 64) {
    float mq = fabsf(p.in[13][tid]), mk = fabsf(p.in[14][tid]);
#pragma unroll
    for (int o = 32; o > 0; o >>= 1) { mq = fmaxf(mq, __shfl_xor(mq, o)); mk = fmaxf(mk, __shfl_xor(mk, o)); }
    if (tid == 0) misc[0] = 8.0f * mq * mk * 1.02f;
  }
  {
    const int c0_ = mcnt[2 * tid], c1_ = mcnt[2 * tid + 1];
    lcnt[2 * tid] = c0_; lcnt[2 * tid + 1] = c1_;
    const int a = 1 + ((c0_ + 255) >> 8), b = 1 + ((c1_ + 255) >> 8);
    int x = a + b;
#pragma unroll
    for (int o = 1; o < 64; o <<= 1) { const int y = __shfl_up(x, o); if (lane >= o) x += y; }
    int* wsum = reinterpret_cast<int*>(misc + 4);
    if (lane == 63) wsum[wid] = x;
    __syncthreads();
    int base = 0;
    for (int w = 0; w < wid; ++w) base += wsum[w];
    const int incl = base + x;
    pfx[1 + 2 * tid] = incl - b; pfx[2 + 2 * tid] = incl;
    if (tid == 0) pfx[0] = 0;
    __syncthreads();
  }
  const float c1 = 0.125f * 1.4426950408889634f, c2 = misc[0] * 1.4426950408889634f;
  const int n_total = pfx[1024];
  struct Meta { int bh, kblk, own, cnt, ent0, ent1; };
  int* qctr = reinterpret_cast<int*>(p.ws + WS_QCTR) + 2;
  const int n_chunks = (n_total + 5) / 6;
  for (int ch = (rep ? (int)blockIdx.x : queue_next(qctr, tid)); ch < n_chunks; ch = (rep ? ch + (int)gridDim.x : queue_next(qctr, tid))) {
  const int it0 = ch * 6, it1 = (it0 + 6 < n_total) ? it0 + 6 : n_total;
  int lcur = 0;
  { int lo = 0, hi = 1024; while (hi - lo > 1) { const int mid = (lo + hi) >> 1; if (pfx[mid] <= it0) lo = mid; else hi = mid; } lcur = lo; }
#define MOBA_E(ITEM, M) do { const int it = (ITEM); \
    while (pfx[lcur + 1] <= it) ++lcur; \
    (M).bh = lcur >> 6; (M).kblk = lcur & 63; const int ltile = it - pfx[lcur] - 1; \
    (M).own = (ltile < 0) ? 1 : 0; \
    (M).cnt = (ltile < 0) ? 256 : lcnt[lcur] - ltile * 256; \
    {   \
      const int idx = wid * 32 + fr; \
      const int* lp = (ltile < 0) ? mlist : mlist + (size_t)(M).bh * 516096 + mlist_off((M).kblk) + ltile * 256; \
      (M).ent0 = lp[(ltile >= 0 && idx < (M).cnt) ? idx : 0]; \
      (M).ent1 = lp[(ltile >= 0 && idx + 16 < (M).cnt) ? idx + 16 : 0]; \
    } } while (0)
  Meta m0, m1, mE;
  bf16x8 q0a[2], q0b[2], q1a[2], q1b[2]; u32x4 kv[8];
  int restQ = 0;
  int lds_blk = -1;
#define MOBA_Q(M, QA, QB, REST) do { \
    const int tqa_ = (M).own ? ((M).kblk * 256 + wid * 32 + fr) : ((M).ent0 >> 2); \
    const int tqb_ = (M).own ? ((M).kblk * 256 + wid * 32 + 16 + fr) : ((M).ent1 >> 2); \
    const u16* qpa = qn + ((size_t)(M).bh * SEQ + tqa_) * 64 + fq * 8; \
    const u16* qpb = qn + ((size_t)(M).bh * SEQ + tqb_) * 64 + fq * 8; \
    QA[0] = *reinterpret_cast<const bf16x8*>(qpa); \
    QA[1] = *reinterpret_cast<const bf16x8*>(qpa + 32); \
    QB[0] = *reinterpret_cast<const bf16x8*>(qpb); \
    QB[1] = *reinterpret_cast<const bf16x8*>(qpb + 32); \
    REST = ((M).bh * 64 + (M).kblk) != lds_blk; \
    lds_blk = (M).bh * 64 + (M).kblk; \
    {   \
      const u16* kb = kn + ((size_t)(M).bh * SEQ + (size_t)(M).kblk * 256) * 64; \
      const u16* vb = vt + (size_t)(M).bh * 64 * SEQ + (size_t)(M).kblk * 256; \
      _Pragma("unroll") for (int i = 0; i < 4; ++i) { \
        const int key = (tid >> 3) + 64 * i, ch = tid & 7; \
        kv[i] = *reinterpret_cast<const u32x4*>(kb + (size_t)key * 64 + ch * 8); \
        const int d = (tid >> 5) + 16 * i, ch2 = tid & 31; \
        kv[4 + i] = *reinterpret_cast<const u32x4*>(vb + (size_t)d * SEQ + ch2 * 8); \
      } \
    } } while (0)
  auto item_body = [&](const int item, Meta& mC, bf16x8 (&qCa)[2], bf16x8 (&qCb)[2], Meta& mN, bf16x8 (&qNa)[2], bf16x8 (&qNb)[2]) __attribute__((always_inline)) {
    const int restC = restQ;
    if (restC) {
      __syncthreads();
#pragma unroll
      for (int i = 0; i < 4; ++i) {
        const int key = (tid >> 3) + 64 * i, ch = tid & 7;
        *(LAS u32x4*)(lds + K_OFF + key * 160 + ch * 16) = kv[i];
        const int d = (tid >> 5) + 16 * i, ch2 = tid & 31;
        *(LAS u32x4*)(lds + VT_OFF + d * 528 + ch2 * 16) = kv[4 + i];
      }
      __syncthreads();
    }
    mN = mE; MOBA_Q(mN, qNa, qNb, restQ);
    MOBA_E((item + 2 < it1) ? item + 2 : it1 - 1, mE);
    const int tqa = mC.own ? (mC.kblk * 256 + wid * 32 + fr) : (mC.ent0 >> 2);
    const int tqb = mC.own ? (mC.kblk * 256 + wid * 32 + 16 + fr) : (mC.ent1 >> 2);
    const int slota = mC.own ? 3 : (mC.ent0 & 3), slotb = mC.own ? 3 : (mC.ent1 & 3);
    f32x4 oa[4], ob[4];
#pragma unroll
    for (int ds = 0; ds < 4; ++ds) { oa[ds] = f32x4{0.f, 0.f, 0.f, 0.f}; ob[ds] = f32x4{0.f, 0.f, 0.f, 0.f}; }
    float lsa = 0.f, lsb = 0.f;
    const int npairs = mC.own ? (wid + 1) : 8;
    if (rep != 1) {
      if (mC.own) attn_wave2p<true>(lds + K_OFF, lds + VT_OFF, qCa, qCb, (npairs + 1) & ~1, tqa & 255, tqb & 255, c1, c2, oa, ob, lsa, lsb, fr, fq);
      else attn_wave2p<false>(lds + K_OFF, lds + VT_OFF, qCa, qCb, 8, 0, 0, c1, c2, oa, ob, lsa, lsb, fr, fq);
    }
    lsa += __shfl_xor(lsa, 16); lsb += __shfl_xor(lsb, 16);
    lsa += __shfl_xor(lsa, 32); lsb += __shfl_xor(lsb, 32);
    if (rep == 0) {
      {
        const size_t pidx = (((size_t)(mC.bh >> 3) * SEQ + tqa) * 8 + (mC.bh & 7)) * 4 + slota;
#pragma unroll
        for (int ds = 0; ds < 4; ++ds) {
          uint2 w; w.x = pack2(oa[ds][0], oa[ds][1]); w.y = pack2(oa[ds][2], oa[ds][3]);
          *reinterpret_cast<uint2*>(opart + pidx * 64 + ds * 16 + fq * 4) = w;
        }
        if (fq == 0) lpart[pidx] = lsa;
      }
      {
        const size_t pidx = (((size_t)(mC.bh >> 3) * SEQ + tqb) * 8 + (mC.bh & 7)) * 4 + slotb;
#pragma unroll
        for (int ds = 0; ds < 4; ++ds) {
          uint2 w; w.x = pack2(ob[ds][0], ob[ds][1]); w.y = pack2(ob[ds][2], ob[ds][3]);
          *reinterpret_cast<uint2*>(opart + pidx * 64 + ds * 16 + fq * 4) = w;
        }
        if (fq == 0) lpart[pidx] = lsb;
      }
    }
    __builtin_amdgcn_s_waitcnt(0xF7A);
  };
  if (it0 < it1) {
    MOBA_E(it0, m0);
    MOBA_Q(m0, q0a, q0b, restQ);
    MOBA_E((it0 + 1 < it1) ? it0 + 1 : it1 - 1, mE);
    __builtin_amdgcn_s_waitcnt(0xF70);
  }
  for (int item = it0; item < it1; item += 2) {
    item_body(item, m0, q0a, q0b, m1, q1a, q1b);
    if (item + 1 < it1) item_body(item + 1, m1, q1a, q1b, m0, q0a, q0b);
  }
  __syncthreads();
  }
#undef MOBA_E
#undef MOBA_Q
}

__device__ __forceinline__ void phase_moba_combine(const MP& p0) {
  const MP p = kparams_load(); (void)p0;
  const int tid = opaque_tid();
  const u16* opart = (const u16*)p.out;
  const float* lpart = (const float*)(p.ws + WS_LPART);
  unsigned char* attn = p.ws + WS_ATTN;
  const size_t G = (size_t)gridDim.x * NTHR, NI = (size_t)TTOK * 8 * 8;
#pragma unroll 1
  for (size_t i0 = (size_t)blockIdx.x * NTHR + tid; i0 < NI; i0 += 4 * G) {
    float4 l4[4]; uint4 pq[4][4];
#pragma unroll
    for (int u = 0; u < 4; ++u) {
      const size_t i = (i0 + u * G < NI) ? i0 + u * G : i0;
      const size_t th = i >> 3;
      const int c = (int)(i & 7) * 8;
      l4[u] = *reinterpret_cast<const float4*>(lpart + th * 4);
#pragma unroll
      for (int s2 = 0; s2 < 4; ++s2) pq[u][s2] = *reinterpret_cast<const uint4*>(opart + (th * 4 + s2) * 64 + c);
    }
#pragma unroll
    for (int u = 0; u < 4; ++u) {
      const size_t i = i0 + u * G;
      if (i < NI) {
        const size_t th = i >> 3;
        const int c = (int)(i & 7) * 8;
        const int t = (int)((th >> 3) % SEQ);
        const int qblk = t >> 8;
        const int nsel = qblk < 3 ? qblk : 3;
        const float lv[4] = {l4[u].x, l4[u].y, l4[u].z, l4[u].w};
        float acc[8] = {0.f, 0.f, 0.f, 0.f, 0.f, 0.f, 0.f, 0.f};
        float l = 0.f;
#pragma unroll
        for (int s2 = 0; s2 < 4; ++s2) {
          const bool ok = (s2 == 3) || (s2 < nsel);
          if (ok) {
            float f[8];
            unpack8(pq[u][s2], f);
#pragma unroll
            for (int j = 0; j < 8; ++j) acc[j] += f[j];
            l += lv[s2];
          }
        }
        const float il = ATT_SCALE / l;
#pragma unroll
        for (int j = 0; j < 8; ++j) acc[j] *= il;
        uint2 o8; o8.x = pack4_fp8_ns(acc[0], acc[1], acc[2], acc[3]); o8.y = pack4_fp8_ns(acc[4], acc[5], acc[6], acc[7]);
        *reinterpret_cast<uint2*>(attn + th * 64 + c) = o8;
      }
    }
  }
}


__device__ __forceinline__ void phase_xattn(const MP& p0) {
  extern __shared__ __attribute__((aligned(16))) unsigned char lds_raw[];
  const MP p = kparams_load(); (void)p0;
  const int tid = opaque_tid();
  LAS unsigned char* lds = (LAS unsigned char*)lds_raw;
  constexpr int K_OFF = 0, VT_OFF = 256 * 272, MISC_OFF = 256 * 272 + 2 * 128 * 272;
  float* misc = reinterpret_cast<float*>(lds_raw + MISC_OFF);
  const u16* proj = (const u16*)(p.ws + WS_PROJ);
  const u16* kmn = (const u16*)(p.ws + WS_KMEMN);
  const u16* vmt = (const u16*)(p.ws + WS_VMT);
  const float* g_cq = p.in[18];
  unsigned char* xattn = p.ws + WS_XATTN;
  const int wid = tid >> 6, lane = tid & 63, fr = lane & 15, fq = lane >> 4;
  __syncthreads();
  if (tid < 64) {
    float mq = fmaxf(fabsf(g_cq[tid]), fabsf(g_cq[tid + 64])), mk = fmaxf(fabsf(p.in[19][tid]), fabsf(p.in[19][tid + 64]));
#pragma unroll
    for (int o = 32; o > 0; o >>= 1) { mq = fmaxf(mq, __shfl_xor(mq, o)); mk = fmaxf(mk, __shfl_xor(mk, o)); }
    if (tid == 0) misc[0] = 11.313708498984761f * mq * mk * 1.02f;
  }
  __syncthreads();
  const float c1 = 0.08838834764831845f * 1.4426950408889634f, c2 = misc[0] * 1.4426950408889634f;
  const int n_items = 2 * 4 * 64, chunk = (n_items + (int)gridDim.x - 1) / (int)gridDim.x;
  const int it0 = blockIdx.x * chunk, it1 = (it0 + chunk < n_items) ? it0 + chunk : n_items;
  int cur_bx = -1;
  for (int item = it0; item < it1; ++item) {
    const int qt = item & 63, bx = item >> 6, xh = bx & 3, b = bx >> 2;
    if (bx != cur_bx) {
      cur_bx = bx;
      __syncthreads();
      const u16* kb = kmn + (size_t)bx * 256 * 128;
      const u16* vb = vmt + (size_t)bx * 128 * 256;
#pragma unroll
      for (int i = 0; i < 8; ++i) {
        const int rrow = (tid >> 4) + 32 * i, ch = tid & 15;
        *(LAS u32x4*)(lds + K_OFF + rrow * 272 + ch * 16) = *reinterpret_cast<const u32x4*>(kb + (size_t)rrow * 128 + ch * 8);
      }
#pragma unroll
      for (int i = 0; i < 8; ++i) {
        const int d = (tid >> 5) + 16 * i, ch = tid & 31;
        *(LAS u32x4*)(lds + VT_OFF + (ch >> 4) * (128 * 272) + d * 272 + (ch & 15) * 16) = *reinterpret_cast<const u32x4*>(vb + (size_t)d * 256 + ch * 8);
      }
      __syncthreads();
    }
    const size_t tok = (size_t)b * SEQ + qt * 256 + wid * 32 + fr;
    bf16x8 qa[4], qb[4];
#define XQ_LOAD(QF, TOK) do { \
      float qv[4][8]; \
      float ss = 0.f; \
      const u16* qp = proj + (TOK) * 5632 + 2048 + xh * 128 + fq * 8; \
      _Pragma("unroll") for (int ks = 0; ks < 4; ++ks) { \
        unpack8(*reinterpret_cast<const uint4*>(qp + ks * 32), qv[ks]); \
        _Pragma("unroll") for (int j = 0; j < 8; ++j) ss += qv[ks][j] * qv[ks][j]; \
      } \
      ss += __shfl_xor(ss, 16); \
      ss += __shfl_xor(ss, 32); \
      const float r = rsqrtf(ss * (1.0f / 128.0f) + 1e-6f); \
      _Pragma("unroll") for (int ks = 0; ks < 4; ++ks) { \
        union { bf16x8 v; unsigned int u[4]; } pk; \
        _Pragma("unroll") for (int j = 0; j < 4; ++j) \
          pk.u[j] = pack2(qv[ks][2 * j] * r * g_cq[ks * 32 + fq * 8 + 2 * j], qv[ks][2 * j + 1] * r * g_cq[ks * 32 + fq * 8 + 2 * j + 1]); \
        QF[ks] = pk.v; \
      } } while (0)
    XQ_LOAD(qa, tok);
    XQ_LOAD(qb, tok + 16);
#undef XQ_LOAD
    f32x4 oa[8], ob[8];
#pragma unroll
    for (int ds = 0; ds < 8; ++ds) { oa[ds] = f32x4{0.f, 0.f, 0.f, 0.f}; ob[ds] = f32x4{0.f, 0.f, 0.f, 0.f}; }
    float lsa = 0.f, lsb = 0.f;
#pragma unroll 1
    for (int hf = 0; hf < 2; ++hf)
      attn_wave2<128, 128>(lds + K_OFF + hf * (128 * 272), lds + VT_OFF + hf * (128 * 272), qa, qb, 4, 0, 0, 0, c1, c2, oa, ob, lsa, lsb, fr, fq);
    lsa += __shfl_xor(lsa, 16); lsb += __shfl_xor(lsb, 16);
    lsa += __shfl_xor(lsa, 32); lsb += __shfl_xor(lsb, 32);
    const float ila = ATT_SCALE / lsa, ilb = ATT_SCALE / lsb;
    unsigned char* op = xattn + tok * 512 + xh * 128 + fq * 4;
#pragma unroll
    for (int ds = 0; ds < 8; ++ds) {
      *reinterpret_cast<unsigned int*>(op + ds * 16) = pack4_fp8_ns(oa[ds][0] * ila, oa[ds][1] * ila, oa[ds][2] * ila, oa[ds][3] * ila);
      *reinterpret_cast<unsigned int*>(op + 16 * 512 + ds * 16) = pack4_fp8_ns(ob[ds][0] * ilb, ob[ds][1] * ilb, ob[ds][2] * ilb, ob[ds][3] * ilb);
    }
  }
}

struct PolGlu {
  static constexpr bool FP8 = false, HALFN = false;
  static constexpr int EPI_VM = 8;
  struct Unit { int pm, pn; };
  typedef OpLin OA; typedef OpLin OB;
  int tid;
  __device__ __forceinline__ int nt() const { return 8; }
  __device__ __forceinline__ bool unit(int i, Unit& u) const {
    const int L = i * gridDim.x + blockIdx.x;
    if (L >= 128 * 8) return false;
    unit_order(L, 128, 8, u.pm, u.pn); return true;
  }
  __device__ __forceinline__ void ops(const Unit& u, OA& A, OB& B) const {
    const MP p = kparams_load();
    A = op_plain(tid, (const u16*)(p.ws + WS_YGELU), (long)u.pm * 256, 512);
    B = op_plain(tid, (const u16*)(p.ws + WS_WT_GLU), (long)u.pn * 256, 512);
  }
  __device__ __forceinline__ void epilogue(acc_t& acc, const Unit& u) const {
    const MP p = kparams_load();
    const int te = opaque_tid(), wr = (te >> 8) & 1, wc = (te >> 6) & 3, fr = te & 15, fq = (te >> 4) & 3;
    const u16* proj = (const u16*)(p.ws + WS_PROJ);
    u16* merged = (u16*)(p.ws + WS_MERGED);
    const int c0 = u.pn * 128 + wc * 32 + fq * 8;
    u32x2 gq[2][4];
#pragma unroll
    for (int ai = 0; ai < 2; ++ai)
#pragma unroll
      for (int m = 0; m < 4; ++m) {
        const size_t row = (size_t)u.pm * 256 + ai * 128 + wr * 64 + m * 16 + fr;
        ASM_LD64(gq[ai][m], reinterpret_cast<const unsigned char*>(proj) + row * 11264 + GATE8_OFF + c0);
      }
    ASM_WAIT8(gq[0][0], gq[0][1], gq[0][2], gq[0][3], gq[1][0], gq[1][1], gq[1][2], gq[1][3]);
#pragma unroll
    for (int ai = 0; ai < 2; ++ai)
#pragma unroll
      for (int m = 0; m < 4; ++m) {
        const size_t row = (size_t)u.pm * 256 + ai * 128 + wr * 64 + m * 16 + fr;
        float g[8], o[8];
        unpack8_fp8(as_uint2(gq[ai][m]), g);
#pragma unroll
        for (int n = 0; n < 2; ++n)
#pragma unroll
          for (int j = 0; j < 4; ++j)
            o[n * 4 + j] = sigmoidf_(g[n * 4 + j]) * acc[ai][0][m][n][j] * sigmoidf_(acc[ai][1][m][n][j]);
        *reinterpret_cast<uint4*>(merged + row * 1024 + c0) = pack8(o);
      }
  }
};
__device__ __forceinline__ void phase_glu(const MP& p0) {
  (void)p0;
  PolGlu pol; pol.tid = opaque_tid();
  gemm_stream(pol);
}

struct PolMoco2 {
  static constexpr bool FP8 = true, HALFN = false;
  static constexpr int EPI_VM = 8;
  float pscale;
  struct Unit { int pm, pn, pass; };
  typedef OpLin OA; typedef OpLin OB;
  int tid;
  __device__ __forceinline__ int nt() const { return 4; }
  __device__ __forceinline__ bool unit(int i, Unit& u) const {
    const int t = i >> 1;
    const int L = t * gridDim.x + blockIdx.x;
    if (L >= 128 * 4) return false;
    unit_order(L, 128, 4, u.pm, u.pn); u.pass = i & 1; return true;
  }
  __device__ __forceinline__ void ops(const Unit& u, OA& A, OB& B) const {
    const MP p = kparams_load();
    const int tid = opaque_tid();
    A = op_plain(tid, (const u16*)(p.ws + (u.pass ? WS_XATTN : WS_ATTN)), (long)u.pm * 256, 256);
    B = op_plain(tid, (const u16*)(p.ws + (u.pass ? WS_WT_CO : WS_WT_MO)), (long)u.pn * 256, 256);
  }
  __device__ __forceinline__ void epilogue(acc_t& acc, const Unit& u) const {
    const MP p = kparams_load();
    const int te = opaque_tid(), wr = (te >> 8) & 1, wc = (te >> 6) & 3, fr = te & 15, fq = (te >> 4) & 3;
    const u16* proj = (const u16*)(p.ws + WS_PROJ);
    u16* merged = (u16*)(p.ws + WS_MERGED);
    const int goff = 2560 + 1024 + u.pass * 1024;
#pragma unroll
    for (int ai = 0; ai < 2; ++ai) {
      uint2 gq[4][2]; uint4 mq[4][2];
#pragma unroll
      for (int m = 0; m < 4; ++m) {
        const size_t row = (size_t)u.pm * 256 + ai * 128 + wr * 64 + m * 16 + fr;
#pragma unroll
        for (int bj = 0; bj < 2; ++bj) {
          const int col = u.pn * 256 + bj * 128 + wc * 32 + fq * 8;
          gq[m][bj] = *reinterpret_cast<const uint2*>(reinterpret_cast<const unsigned char*>(proj) + row * 11264 + GATE8_OFF + (goff - 2560) + col);
          mq[m][bj] = *reinterpret_cast<const uint4*>(merged + row * 1024 + col);
        }
      }
#pragma unroll
      for (int m = 0; m < 4; ++m) {
        const size_t row = (size_t)u.pm * 256 + ai * 128 + wr * 64 + m * 16 + fr;
#pragma unroll
        for (int bj = 0; bj < 2; ++bj) {
          const int col = u.pn * 256 + bj * 128 + wc * 32 + fq * 8;
          float g[8], o[8];
          unpack8_fp8(gq[m][bj], g);
          unpack8(mq[m][bj], o);
#pragma unroll
          for (int n = 0; n < 2; ++n)
#pragma unroll
            for (int j = 0; j < 4; ++j) o[n * 4 + j] += (pscale * (1.0f / (MOE_WSCALE * ATT_SCALE))) * sigmoidf_(g[n * 4 + j]) * acc[ai][bj][m][n][j];
          *reinterpret_cast<uint4*>(merged + row * 1024 + col) = pack8(o);
        }
      }
      asm volatile("" ::: "memory");
    }
  }
};
__device__ __forceinline__ void phase_moco(const MP& p0, int rep = 0) {
  (void)p0;
  PolMoco2 pol; pol.tid = opaque_tid(); pol.pscale = rep ? 0.0f : 1.0f;
  gemm_stream(pol);
}

struct PolOut {
  static constexpr bool FP8 = false, HALFN = false;
  static constexpr int EPI_VM = 16;
  struct Unit { int pm, pn; };
  typedef OpLin OA; typedef OpLin OB;
  int tid;
  __device__ __forceinline__ int nt() const { return 16; }
  __device__ __forceinline__ bool unit(int i, Unit& u) const {
    const int L = i * gridDim.x + blockIdx.x;
    if (L >= 128 * 4) return false;
    unit_order(L, 128, 4, u.pm, u.pn); return true;
  }
  __device__ __forceinline__ void ops(const Unit& u, OA& A, OB& B) const {
    const MP p = kparams_load();
    A = op_plain(tid, (const u16*)(p.ws + WS_MERGED), (long)u.pm * 256, 1024);
    B = op_plain(tid, (const u16*)(p.ws + WS_WT_OUT), (long)u.pn * 256, 1024);
  }
  __device__ __forceinline__ void epilogue(acc_t& acc, const Unit& u) const {
    const MP p = kparams_load();
    const int te = opaque_tid(), wr = (te >> 8) & 1, wc = (te >> 6) & 3, fr = te & 15, fq = (te >> 4) & 3;
    const float* xb = p.in[0] + ((size_t)u.pm * 256 + wr * 64 + fr) * 1024 + u.pn * 256 + wc * 32 + fq * 8;
    float* ob = p.out + ((size_t)u.pm * 256 + wr * 64 + fr) * 1024 + u.pn * 256 + wc * 32 + fq * 8;
    f32x4 xa[4], xc[4];
#define OUT_LD(BUF, K)                                                                                                   \
    {                                                                                                                     \
      const float* xp = xb + (size_t)(((K) >> 2) * 128 + ((K) & 3) * 16) * 1024;                                           \
      asm volatile("global_load_dwordx4 %0, %1, off" : "=v"(BUF[0]) : "v"(xp) : "memory");                              \
      asm volatile("global_load_dwordx4 %0, %1, off offset:16" : "=v"(BUF[1]) : "v"(xp) : "memory");                    \
      asm volatile("global_load_dwordx4 %0, %1, off offset:512" : "=v"(BUF[2]) : "v"(xp) : "memory");                   \
      asm volatile("global_load_dwordx4 %0, %1, off offset:528" : "=v"(BUF[3]) : "v"(xp) : "memory");                   \
    }
#define OUT_WAIT(N, BUF) asm volatile("s_waitcnt vmcnt(" #N ")" : "+v"(BUF[0]), "+v"(BUF[1]), "+v"(BUF[2]), "+v"(BUF[3]) :: "memory")
#define OUT_ST(BUF, K)                                                                                                   \
    {                                                                                                                     \
      float* op = ob + (size_t)(((K) >> 2) * 128 + ((K) & 3) * 16) * 1024;                                                 \
      _Pragma("unroll") for (int bj = 0; bj < 2; ++bj)                                                                    \
        _Pragma("unroll") for (int n = 0; n < 2; ++n) {                                                                   \
          const f32x4 a = acc[(K) >> 2][bj][(K) & 3][n], xq = BUF[bj * 2 + n];                                             \
          *reinterpret_cast<float4*>(op + bj * 128 + n * 4) = make_float4(xq[0] + a[0], xq[1] + a[1], xq[2] + a[2], xq[3] + a[3]); \
        }                                                                                                                 \
    }
    OUT_LD(xa, 0) OUT_LD(xc, 1)
    OUT_WAIT(4, xa); OUT_ST(xa, 0) OUT_LD(xa, 2)
    OUT_WAIT(8, xc); OUT_ST(xc, 1) OUT_LD(xc, 3)
    OUT_WAIT(8, xa); OUT_ST(xa, 2) OUT_LD(xa, 4)
    OUT_WAIT(8, xc); OUT_ST(xc, 3) OUT_LD(xc, 5)
    OUT_WAIT(8, xa); OUT_ST(xa, 4) OUT_LD(xa, 6)
    OUT_WAIT(8, xc); OUT_ST(xc, 5) OUT_LD(xc, 7)
    OUT_WAIT(8, xa); OUT_ST(xa, 6)
    OUT_WAIT(4, xc); OUT_ST(xc, 7)
#undef OUT_LD
#undef OUT_WAIT
#undef OUT_ST
  }
};
__device__ __forceinline__ void phase_outproj(const MP& p0) {
  (void)p0;
  PolOut pol; pol.tid = opaque_tid();
  gemm_stream(pol);
}

__device__ __forceinline__ void phase_route(const MP& p0, int rep = 0) {
  extern __shared__ __attribute__((aligned(16))) unsigned char lds_raw[];
  const MP p = kparams_load(); (void)p0;
  const float* x1 = p.out;
  const float* g_ffn = p.in[22];
  const float* b_router = p.in[24];
  const float* gw = reinterpret_cast<const float*>(p.ws + WS_GW);
  unsigned char* h2 = p.ws + WS_H2;
  int* list = reinterpret_cast<int*>(p.ws + WS_LIST);
  float* topw = reinterpret_cast<float*>(p.ws + WS_TOPW);
  int* cnt = reinterpret_cast<int*>(p.ws + WS_CNT);
  const int tid = opaque_tid(), wid = tid >> 6, lane = tid & 63;
  float* gwl = reinterpret_cast<float*>(lds_raw);
  float* lg = reinterpret_cast<float*>(lds_raw + 131072) + wid * (16 * 33);
  int* hist = reinterpret_cast<int*>(lds_raw + 131072 + 8 * 16 * 33 * 4);
  int* gbase = hist + 32;
  const int i16 = lane & 15, kk = lane >> 4;
  __syncthreads();
  {
    float4 gv[16];
#pragma unroll
    for (int j = 0; j < 16; ++j) gv[j] = *reinterpret_cast<const float4*>(gw + (size_t)(tid + j * NTHR) * 4);
#pragma unroll
    for (int j = 0; j < 16; ++j) {
      const int i = tid + j * NTHR, k = i >> 3, e4 = (i & 7) * 4;
      *reinterpret_cast<float4*>(gwl + k * 32 + (e4 ^ (((k >> 2) & 1) << 4))) = gv[j];
    }
  }
  __syncthreads();
  for (int bt = blockIdx.x; bt < TTOK / 128; bt += gridDim.x) {
    const int tok0 = bt * 128 + wid * 16;
    if (tid < 32) hist[tid] = 0;
    __syncthreads();
    f32x4 acc0 = {0.f, 0.f, 0.f, 0.f}, acc1 = {0.f, 0.f, 0.f, 0.f};
    float ssq = 0.f;
    const float* xr = x1 + (size_t)(tok0 + i16) * 1024 + 4 * kk;
#define RT_LD(BUF, S0) { _Pragma("unroll") for (int u = 0; u < 8; ++u) BUF[u] = *reinterpret_cast<const float4*>(xr + 16 * ((S0) + u)); }
#define RT_MM(BUF, S0)                                                                                    \
    { _Pragma("unroll") for (int u = 0; u < 8; ++u) {                                                      \
        const int s = (S0) + u;                                                                            \
        const float4 a = BUF[u];                                                                           \
        ssq += a.x * a.x + a.y * a.y + a.z * a.z + a.w * a.w;                                              \
        const float* wb = gwl + (16 * s + 4 * kk) * 32;                                                    \
        const int sw = (kk & 1) << 4;                                                                      \
        float av[4] = {a.x, a.y, a.z, a.w};                                                                \
        _Pragma("unroll") for (int r = 0; r < 4; ++r) {                                                    \
          float b0 = wb[r * 32 + (i16 ^ sw)], b1 = wb[r * 32 + ((i16 + 16) ^ sw)];                         \
          acc0 = __builtin_amdgcn_mfma_f32_16x16x4f32(av[r], b0, acc0, 0, 0, 0);                           \
          acc1 = __builtin_amdgcn_mfma_f32_16x16x4f32(av[r], b1, acc1, 0, 0, 0);                           \
        }                                                                                                  \
      } }
    {
      float4 a8[8], b8[8];
      RT_LD(a8, 0)
#pragma unroll 1
      for (int s0 = 0; s0 < 64; s0 += 16) {
        RT_LD(b8, s0 + 8)
        RT_MM(a8, s0)
        if (s0 + 16 < 64) RT_LD(a8, s0 + 16)
        RT_MM(b8, s0 + 8)
      }
    }
#undef RT_LD
#undef RT_MM
    ssq += __shfl_xor(ssq, 16);
    ssq += __shfl_xor(ssq, 32);
    const float rstd = rsqrtf(ssq * (1.0f / 1024.0f) + 1e-6f);
#pragma unroll
    for (int r = 0; r < 4; ++r) {
      lg[(kk * 4 + r) * 33 + i16] = acc0[r];
      lg[(kk * 4 + r) * 33 + 16 + i16] = acc1[r];
    }
    asm volatile("s_waitcnt lgkmcnt(0)" ::: "memory");
    float4 gf[4], ha[4][4], hb[4][4];
#pragma unroll
    for (int q = 0; q < 4; ++q) gf[q] = *reinterpret_cast<const float4*>(g_ffn + q * 256 + lane * 4);
#define RT_HL0 { _Pragma("unroll") for (int jj = 0; jj < 4; ++jj) _Pragma("unroll") for (int q = 0; q < 4; ++q) \
      ha[jj][q] = *reinterpret_cast<const float4*>(x1 + (size_t)(tok0 + jj) * 1024 + q * 256 + lane * 4); }
    RT_HL0
#undef RT_HL0
    int sel_e[4] = {0, 0, 0, 0};
    float sel_w[4] = {0.f, 0.f, 0.f, 0.f};
    int lpos[4] = {0, 0, 0, 0};
    if (lane < 16 && rep == 0) {
      float v[32];
#pragma unroll
      for (int e = 0; e < 32; ++e) v[e] = lg[lane * 33 + e] * rstd + b_router[e];
      unsigned used = 0u;
      float tv[4];
#pragma unroll
      for (int k = 0; k < 4; ++k) {
        float best = -INFINITY; int bi = 0;
#pragma unroll
        for (int e = 0; e < 32; ++e) {
          bool ok = !((used >> e) & 1u);
          if (ok && v[e] > best) { best = v[e]; bi = e; }
        }
        used |= (1u << bi);
        tv[k] = best; sel_e[k] = bi;
      }
      float e0 = 1.0f, e1 = expf(tv[1] - tv[0]), e2 = expf(tv[2] - tv[0]), e3 = expf(tv[3] - tv[0]);
      float inv = 1.0f / (e0 + e1 + e2 + e3);
      sel_w[0] = e0 * inv; sel_w[1] = e1 * inv; sel_w[2] = e2 * inv; sel_w[3] = e3 * inv;
#pragma unroll
      for (int k = 0; k < 4; ++k) lpos[k] = atomicAdd(&hist[sel_e[k]], 1);
    }
#define RT_HL(BUF, J0) { _Pragma("unroll") for (int jj = 0; jj < 4; ++jj) _Pragma("unroll") for (int q = 0; q < 4; ++q) \
      BUF[jj][q] = *reinterpret_cast<const float4*>(x1 + (size_t)(tok0 + (J0) + jj) * 1024 + q * 256 + lane * 4); }
#define RT_HS(BUF, J0) { _Pragma("unroll") for (int jj = 0; jj < 4; ++jj) {                                              \
      const float rs = __shfl(rstd, (J0) + jj);                                                                          \
      unsigned char* hrow = h2 + (size_t)(tok0 + (J0) + jj) * 1024;                                                      \
      _Pragma("unroll") for (int q = 0; q < 4; ++q) {                                                                    \
        const int c = q * 256 + lane * 4;                                                                                \
        *reinterpret_cast<unsigned int*>(hrow + c) = pack4_fp8(BUF[jj][q].x * rs * gf[q].x, BUF[jj][q].y * rs * gf[q].y, BUF[jj][q].z * rs * gf[q].z, BUF[jj][q].w * rs * gf[q].w); \
      } } }
    RT_HL(hb, 4)
    RT_HS(ha, 0)
    RT_HL(ha, 8)
    RT_HS(hb, 4)
    RT_HL(hb, 12)
    RT_HS(ha, 8)
    RT_HS(hb, 12)
#undef RT_HS
#undef RT_HL
    __syncthreads();
    if (tid < 32) gbase[tid] = (hist[tid] && rep == 0) ? atomicAdd(&cnt[tid], hist[tid]) : 0;
    __syncthreads();
    if (lane < 16 && rep == 0) {
      int tok = tok0 + lane;
#pragma unroll
      for (int k = 0; k < 4; ++k) {
        int e = sel_e[k];
        list[(size_t)e * TTOK + gbase[e] + lpos[k]] = tok * 4 + k;
        topw[tok * 4 + k] = sel_w[k];
        reinterpret_cast<int*>(p.ws + WS_TOPP)[tok * 4 + k] = (e << 16) | (gbase[e] + lpos[k]);
      }
    }
    __syncthreads();
  }
}

struct MoeMap { int tilebase[33]; int rowbase[33]; int cnt[32]; unsigned char rt2e[1024]; };
__device__ __forceinline__ MoeMap* moe_map_build(const MP& p) {
  extern __shared__ __attribute__((aligned(16))) unsigned char lds_raw[];
  MoeMap* mm = reinterpret_cast<MoeMap*>(lds_raw + LDS_MISC_OFF);
  const int* cnt = reinterpret_cast<const int*>(p.ws + WS_CNT);
  if (threadIdx.x == 0) {
    int tb = 0;
    for (int e = 0; e < 32; ++e) {
      int c = cnt[e];
      mm->cnt[e] = c; mm->tilebase[e] = tb; mm->rowbase[e] = tb * 256;
      tb += (c + 255) >> 8;
    }
    mm->tilebase[32] = tb; mm->rowbase[32] = tb * 256;
  }
  __syncthreads();
  for (int t = threadIdx.x; t < mm->tilebase[32]; t += NTHR) { int e = 0; while (mm->tilebase[e + 1] <= t) ++e; mm->rt2e[t] = (unsigned char)e; }
  __syncthreads();
  return mm;
}

struct PolMoe1 {
  static constexpr bool FP8 = true, HALFN = false;
  static constexpr int EPI_VM = 0;
  struct Unit { int e, rt, ct, nvalid, rowbase, dup; int ent[2][2]; };
  typedef OpGat OA; typedef OpLin OB;
  int tid; MoeMap* mm; int total;
  __device__ __forceinline__ int nt() const { return 8; }
#ifndef DUPK
#define DUPK 1
#endif
  __device__ __forceinline__ bool unit(int i0, Unit& u) const {
    const int i = i0 / DUPK; u.dup = i0 % DUPK;
    const int sidx = i * (gridDim.x >> 3) + (blockIdx.x >> 3);
    const int rtg = (sidx >> 3) * 8 + (blockIdx.x & 7);
    const int tile = rtg * 8 + (sidx & 7);
    if (rtg >= (total >> 3)) return false;
    int e = __builtin_amdgcn_readfirstlane((int)mm->rt2e[rtg]);
    u.e = e; u.ct = tile & 7; u.rt = __builtin_amdgcn_readfirstlane(rtg - mm->tilebase[e]); u.nvalid = __builtin_amdgcn_readfirstlane(mm->cnt[e]) - u.rt * 256;
    u.rowbase = __builtin_amdgcn_readfirstlane(mm->rowbase[e]);
    const MP p = kparams_load();
    const int* le = reinterpret_cast<const int*>(p.ws + WS_LIST) + (size_t)u.e * TTOK + u.rt * 256;
#pragma unroll
    for (int i = 0; i < 2; ++i) {
      int R, C; stage_rc(tid * 16 + i * 8192, R, C);
#pragma unroll
      for (int h = 0; h < 2; ++h) { const int r = h * 128 + R; u.ent[h][i] = le[(r < u.nvalid) ? r : 0]; }
    }
    return true;
  }
  __device__ __forceinline__ void ops(const Unit& u, OA& A, OB& B) const {
    const MP p = kparams_load();
    const int tid = opaque_tid();
    A.base = reinterpret_cast<const char*>(p.ws + WS_H2); A.kstep = 128;
#pragma unroll
    for (int i = 0; i < 2; ++i) {
      int R, C; stage_rc(tid * 16 + i * 8192, R, C);
#pragma unroll
      for (int h = 0; h < 2; ++h) A.voff[h][i] = (unsigned)(((u.ent[h][i] >> 2) * 512 + C) * 2);
    }
    B = op_plain(tid, (const u16*)(p.ws + WS_WT_GU) + (size_t)u.e * 2048 * 512, u.ct * 256, 512);
#ifdef HOTK
    if (u.dup != DUPK - 1) { A.kstep = 0; B.kstep = 0; }
#endif
  }
  __device__ __forceinline__ void epilogue(acc_t& acc, const Unit& u) const {
#ifndef DUP_EPI
    if (u.dup != DUPK - 1) return;
#endif
    const MP p = kparams_load();
    const int te = opaque_tid(), wr = (te >> 8) & 1, wc = (te >> 6) & 3, fr = te & 15, fq = (te >> 4) & 3;
    const float* bg = p.in[26] + (size_t)u.e * 2048;
    unsigned char* arow = p.ws + WS_ACT + (size_t)(u.rowbase + u.rt * 256) * 1024;
    const int c0 = u.ct * 128 + wc * 32 + fq * 8;
    float bgate[8], bup[8];
#pragma unroll
    for (int q = 0; q < 8; ++q) { bgate[q] = bg[c0 + q]; bup[q] = bg[1024 + c0 + q]; }
#pragma unroll
    for (int ai = 0; ai < 2; ++ai)
#pragma unroll
      for (int m = 0; m < 4; ++m) {
        const int r = ai * 128 + wr * 64 + m * 16 + fr;
        float a8[8];
#pragma unroll
        for (int n = 0; n < 2; ++n)
#pragma unroll
          for (int j = 0; j < 4; ++j) {
            float ga = acc[ai][0][m][n][j] * (1.0f / MOE_WSCALE) + bgate[n * 4 + j];
            float up = acc[ai][1][m][n][j] * (1.0f / MOE_WSCALE) + bup[n * 4 + j];
            ga = fminf(ga, 7.0f);
            up = fminf(fmaxf(up, -7.0f), 7.0f);
            const float sg = __builtin_amdgcn_rcpf(1.f + __builtin_amdgcn_exp2f(-1.702f * 1.4426950408889634f * ga));
            a8[n * 4 + j] = ga * sg * (up + 1.0f);
          }
        { uint2 o8; o8.x = pack4_fp8_ns(a8[0], a8[1], a8[2], a8[3]); o8.y = pack4_fp8_ns(a8[4], a8[5], a8[6], a8[7]); *reinterpret_cast<uint2*>(arow + (size_t)r * 1024 + c0) = o8; }
      }
  }
};
__device__ __forceinline__ void phase_moe1(const MP& p0) {
  const MP p = kparams_load(); (void)p0;
#ifdef CLOCK_PROBE
  const unsigned long long c0 = clock64(), r0 = wall_clock64();
#endif
  PolMoe1 pol; pol.mm = moe_map_build(p); pol.tid = opaque_tid(); pol.total = pol.mm->tilebase[32] * 8;
  gemm_stream(pol);
#ifdef CLOCK_PROBE
  const unsigned long long c1 = clock64(), r1 = wall_clock64();
  if (blockIdx.x == 0 && threadIdx.x == 0) {
    float ghz = (float)(c1 - c0) / ((float)(r1 - r0) * 10.0f);
    reinterpret_cast<float*>(p.ws + WS_CNT)[1000] = floorf(ghz * 4.0f) * 0.25f;
  }
#endif
}

struct PolMoe2 {
  static constexpr bool FP8 = true, HALFN = false;
  static constexpr int EPI_VM = 16;
  struct Unit { int e, rt, ct, nvalid, rowbase, dup; };
  typedef OpLin OA; typedef OpLin OB;
  int tid; MoeMap* mm; int total;
  __device__ __forceinline__ int nt() const { return 8; }
#ifndef DUPK2
#define DUPK2 1
#endif
  __device__ __forceinline__ bool unit(int i0, Unit& u) const {
    const int i = i0 / DUPK2; u.dup = i0 % DUPK2;
    const int sidx = i * (gridDim.x >> 3) + (blockIdx.x >> 3);
    const int rtg = (sidx >> 2) * 8 + (blockIdx.x & 7);
    const int tile = rtg * 4 + (sidx & 3);
    if (rtg >= (total >> 2)) return false;
    int e = __builtin_amdgcn_readfirstlane((int)mm->rt2e[rtg]);
    u.e = e; u.ct = tile & 3; u.rt = __builtin_amdgcn_readfirstlane(rtg - mm->tilebase[e]); u.nvalid = __builtin_amdgcn_readfirstlane(mm->cnt[e]) - u.rt * 256;
    u.rowbase = __builtin_amdgcn_readfirstlane(mm->rowbase[e]);
    return true;
  }
  __device__ __forceinline__ void ops(const Unit& u, OA& A, OB& B) const {
    const MP p = kparams_load();
    const int tid = opaque_tid();
    A = op_plain(tid, (const u16*)(p.ws + WS_ACT), (long)u.rowbase + u.rt * 256, 512);
    B = op_plain(tid, (const u16*)(p.ws + WS_WT_DOWN) + (size_t)u.e * 1024 * 512, u.ct * 256, 512);
  }
  __device__ __forceinline__ void epilogue(acc_t& acc, const Unit& u) const {
#ifndef DUP_EPI2
    if (u.dup != DUPK2 - 1) return;
#endif
    const MP p = kparams_load();
    const int te = opaque_tid(), wr = (te >> 8) & 1, wc = (te >> 6) & 3, fr = te & 15, fq = (te >> 4) & 3;
    unsigned char* ysort = p.ws + WS_YSLOT + (size_t)(u.rowbase + u.rt * 256) * 1024;
    const float* bd = p.in[28] + (size_t)u.e * 1024;
    constexpr float WS1 = 1.0f / MOE_WSCALE;
    f32x4 bb[2][2];
#pragma unroll
    for (int bj = 0; bj < 2; ++bj) {
      const float* bp = bd + u.ct * 256 + bj * 128 + wc * 32 + fq * 8;
      asm volatile("global_load_dwordx4 %0, %1, off" : "=v"(bb[bj][0]) : "v"(bp) : "memory");
      asm volatile("global_load_dwordx4 %0, %1, off offset:16" : "=v"(bb[bj][1]) : "v"(bp) : "memory");
    }
    asm volatile("s_waitcnt vmcnt(0)" : "+v"(bb[0][0]), "+v"(bb[0][1]), "+v"(bb[1][0]), "+v"(bb[1][1]) :: "memory");
#pragma unroll
    for (int bj = 0; bj < 2; ++bj) {
      const int col = u.ct * 256 + bj * 128 + wc * 32 + fq * 8;
      const float4 b0 = make_float4(bb[bj][0][0], bb[bj][0][1], bb[bj][0][2], bb[bj][0][3]), b1 = make_float4(bb[bj][1][0], bb[bj][1][1], bb[bj][1][2], bb[bj][1][3]);
#pragma unroll
      for (int ai = 0; ai < 2; ++ai)
#pragma unroll
        for (int m = 0; m < 4; ++m) {
          const int r = ai * 128 + wr * 64 + m * 16 + fr;
          uint2 o;
          o.x = pack4_fp8_ns(WS1 * acc[ai][bj][m][0][0] + b0.x, WS1 * acc[ai][bj][m][0][1] + b0.y, WS1 * acc[ai][bj][m][0][2] + b0.z, WS1 * acc[ai][bj][m][0][3] + b0.w);
          o.y = pack4_fp8_ns(WS1 * acc[ai][bj][m][1][0] + b1.x, WS1 * acc[ai][bj][m][1][1] + b1.y, WS1 * acc[ai][bj][m][1][2] + b1.z, WS1 * acc[ai][bj][m][1][3] + b1.w);
          *reinterpret_cast<uint2*>(ysort + (size_t)r * 1024 + col) = o;
        }
    }
  }
};
__device__ __forceinline__ void phase_moe2(const MP& p0) {
  const MP p = kparams_load(); (void)p0;
  PolMoe2 pol; pol.mm = moe_map_build(p); pol.tid = opaque_tid(); pol.total = pol.mm->tilebase[32] * 4;
  gemm_stream(pol);
}

__device__ __forceinline__ void phase_moe_combine(const MP& p0, int rep = 0) {
  const MP p = kparams_load(); (void)p0;
  const int tid0 = opaque_tid();
  MoeMap* mm = moe_map_build(p);
  const unsigned char* ysort = p.ws + WS_YSLOT;
  const float* topw = reinterpret_cast<const float*>(p.ws + WS_TOPW);
  const int* topp = reinterpret_cast<const int*>(p.ws + WS_TOPP);
  float* out = p.out;
  const size_t nvec = (size_t)TTOK * 1024 / 8, G = (size_t)gridDim.x * NTHR;
#pragma unroll 1
  for (size_t i0 = (size_t)blockIdx.x * NTHR + tid0; i0 < nvec; i0 += 2 * G) {
    float4 w4[2]; int4 p4[2];
#pragma unroll
    for (int u = 0; u < 2; ++u) {
      const size_t i = (i0 + u * G < nvec) ? i0 + u * G : i0;
      const size_t tok = i >> 7;
      w4[u] = *reinterpret_cast<const float4*>(topw + tok * 4);
      p4[u] = *reinterpret_cast<const int4*>(topp + tok * 4);
    }
    float4 xa[2], xb[2]; uint2 y8[2][4];
#pragma unroll
    for (int u = 0; u < 2; ++u) {
      const size_t i = (i0 + u * G < nvec) ? i0 + u * G : i0;
      const size_t tok = i >> 7;
      const int c = (int)(i & 127) * 8;
      const int pv[4] = {p4[u].x, p4[u].y, p4[u].z, p4[u].w};
      xa[u] = *reinterpret_cast<const float4*>(out + tok * 1024 + c);
      xb[u] = *reinterpret_cast<const float4*>(out + tok * 1024 + c + 4);
#pragma unroll
      for (int k = 0; k < 4; ++k) {
        const size_t row = (size_t)mm->rowbase[pv[k] >> 16] + (pv[k] & 0xffff);
        y8[u][k] = *reinterpret_cast<const uint2*>(ysort + row * 1024 + c);
      }
    }
#pragma unroll
    for (int u = 0; u < 2; ++u) {
      const size_t i = i0 + u * G;
      if (i < nvec) {
        const size_t tok = i >> 7;
        const int c = (int)(i & 127) * 8;
        const float ps = rep ? 0.0f : 1.0f;
        const float wv[4] = {w4[u].x * ps, w4[u].y * ps, w4[u].z * ps, w4[u].w * ps};
        float v[8] = {xa[u].x, xa[u].y, xa[u].z, xa[u].w, xb[u].x, xb[u].y, xb[u].z, xb[u].w};
#pragma unroll
        for (int k = 0; k < 4; ++k) {
          const f32v2 f0 = __builtin_amdgcn_cvt_pk_f32_fp8((int)y8[u][k].x, false), f1 = __builtin_amdgcn_cvt_pk_f32_fp8((int)y8[u][k].x, true);
          const f32v2 f2 = __builtin_amdgcn_cvt_pk_f32_fp8((int)y8[u][k].y, false), f3 = __builtin_amdgcn_cvt_pk_f32_fp8((int)y8[u][k].y, true);
          v[0] = fmaf(wv[k], f0[0], v[0]); v[1] = fmaf(wv[k], f0[1], v[1]); v[2] = fmaf(wv[k], f1[0], v[2]); v[3] = fmaf(wv[k], f1[1], v[3]);
          v[4] = fmaf(wv[k], f2[0], v[4]); v[5] = fmaf(wv[k], f2[1], v[5]); v[6] = fmaf(wv[k], f3[0], v[6]); v[7] = fmaf(wv[k], f3[1], v[7]);
        }
        *reinterpret_cast<float4*>(out + tok * 1024 + c) = make_float4(v[0], v[1], v[2], v[3]);
        *reinterpret_cast<float4*>(out + tok * 1024 + c + 4) = make_float4(v[4], v[5], v[6], v[7]);
      }
    }
  }
}

#define XB_TMO      128
#define XB_XCNT(j)  (256  + 64 * (j))
#define XB_XSUB(j)  (1280 + 64 * (j))
#define XB_XGEN(j)  (2304 + 64 * (j))
#define XB_TOP      3328
#define XB_TOPGEN   3392
#define XCD_BAR_WORDS 3456
#define XB_SPIN_CAP (1u << 20)
#define LDS_BAR_OFF (LDS_MISC_OFF + 2048)
__device__ __forceinline__ unsigned xb_ld(unsigned* p) { return __hip_atomic_load(p, __ATOMIC_RELAXED, __HIP_MEMORY_SCOPE_AGENT); }
__device__ __forceinline__ unsigned xb_add(unsigned* p, unsigned v) { return __hip_atomic_fetch_add(p, v, __ATOMIC_RELAXED, __HIP_MEMORY_SCOPE_AGENT); }
__device__ __forceinline__ unsigned xb_xcc_id() { return (unsigned)__builtin_amdgcn_s_getreg((3 << 11) | 20) & 0xFu; }
#define XB_SPIN(cond, bar) do { unsigned _sp = 0; while (cond) { __builtin_amdgcn_s_sleep(1); \
    if ((++_sp & 255u) == 0u) { if (xb_ld(&(bar)[XB_TMO])) break; if (_sp > XB_SPIN_CAP) { atomicAdd(&(bar)[XB_TMO], 1u); break; } } } } while (0)
__device__ __forceinline__ void xcd_barrier_post() {
  extern __shared__ __attribute__((aligned(16))) unsigned char lds_raw[];
  if (threadIdx.x == 0) {
    const MP p = kparams_load();
    unsigned* bar = reinterpret_cast<unsigned*>(p.ws + WS_BAR);
    volatile LAS unsigned* st = (volatile LAS unsigned*)((LAS unsigned char*)lds_raw + LDS_BAR_OFF);
    st[0] = 0u; st[1] = 0u;
    (void)xb_add(&bar[XB_XCNT(xb_xcc_id())], 1u);
  }
  __syncthreads();
}
__device__ __forceinline__ void xcd_barrier_complete(unsigned* bar, unsigned x, unsigned& nloc, unsigned& nx) {
  const unsigned G = gridDim.x * gridDim.y * gridDim.z;
  unsigned sum, cnt, mine, sp = 0u;
  for (;;) {
    sum = 0u; cnt = 0u; mine = 0u;
#pragma unroll
    for (unsigned j = 0; j < 16; ++j) { const unsigned c = xb_ld(&bar[XB_XCNT(j)]); sum += c; cnt += (c > 0u) ? 1u : 0u; mine = (j == x) ? c : mine; }
    if (sum == G) break;
    __builtin_amdgcn_s_sleep(1);
    if ((++sp & 255u) == 0u) { if (xb_ld(&bar[XB_TMO])) break; if (sp > XB_SPIN_CAP) { atomicAdd(&bar[XB_TMO], 1u); break; } }
  }
  nloc = mine > 0u ? mine : 1u; nx = cnt > 0u ? cnt : 1u;
}
__device__ __forceinline__ void xcd_barrier() {
  extern __shared__ __attribute__((aligned(16))) unsigned char lds_raw[];
  asm volatile("s_waitcnt vmcnt(0)" ::: "memory");
  __syncthreads();
  if (threadIdx.x == 0) {
    const MP p = kparams_load();
    unsigned* bar = reinterpret_cast<unsigned*>(p.ws + WS_BAR);
    volatile LAS unsigned* st = (volatile LAS unsigned*)((LAS unsigned char*)lds_raw + LDS_BAR_OFF);
    const unsigned x = xb_xcc_id();
    __builtin_amdgcn_s_waitcnt(0);
    unsigned nloc = st[0], nx = st[1];
    if (nloc == 0u) { xcd_barrier_complete(bar, x, nloc, nx); st[0] = nloc; st[1] = nx; }
    const unsigned old = xb_add(&bar[XB_XSUB(x)], 1u);
    const unsigned gen = old / nloc;
    if (old + 1u == (gen + 1u) * nloc) {
      __builtin_amdgcn_fence(__ATOMIC_RELEASE, "agent");
      asm volatile("s_waitcnt vmcnt(0)" ::: "memory");
      const unsigned og = xb_add(&bar[XB_TOP], 1u);
      const unsigned tg = og / nx;
      if (og + 1u == (tg + 1u) * nx) xb_add(&bar[XB_TOPGEN], 1u);
      else XB_SPIN(xb_ld(&bar[XB_TOPGEN]) == tg, bar);
      __builtin_amdgcn_fence(__ATOMIC_ACQUIRE, "agent");
      xb_add(&bar[XB_XGEN(x)], 1u);
      asm volatile("s_waitcnt vmcnt(0)" ::: "memory");
    } else {
      XB_SPIN(xb_ld(&bar[XB_XGEN(x)]) == gen, bar);
      __builtin_amdgcn_fence(__ATOMIC_ACQUIRE, "agent");
      asm volatile("s_waitcnt vmcnt(0)" ::: "memory");
    }
  }
  __syncthreads();
}

enum { PH_PREP = 0, PH_GEMM1, PH_S5S_KPREP, PH_SCAN_GATE, PH_S5Y_MOBA_XATTN, PH_MOBAC_GLU, PH_MOCO, PH_OUT, PH_ROUTE, PH_MOE1, PH_MOE2,
       PH_COMBINE, PH_COUNT };

#ifndef REP_PHASE
#define REP_PHASE -1
#endif
#ifndef REP_COUNT
#define REP_COUNT 1
#endif
#ifndef ONLY
#define ONLY -1
#endif
#define SLOT(n, body) if (ONLY < 0 || ONLY == (n)) for (int _rep = 0; _rep < ((REP_PHASE == (n)) ? 1 + REP_COUNT : 1); ++_rep) { if (_rep) xcd_barrier(); body; }
__global__ void __launch_bounds__(NTHR) mega(MP p) {
  phase_prep_mix(p); __syncthreads(); phase_prep_moe(p); __syncthreads();
  xcd_barrier_post();
  xcd_barrier();
  SLOT(1, phase_gemm1(p));
  xcd_barrier();
  if (REP_PHASE == 200) { for (int q = 0; q < 20; ++q) xcd_barrier(); }
  SLOT(2, { phase_s5s(p); phase_kvgemm(p); __syncthreads(); phase_kprep(p); __syncthreads(); });
  xcd_barrier();
  SLOT(3, { phase_s5scan(p); phase_kmemnorm(p); }); __syncthreads(); phase_gate(p); if (REP_PHASE == 31) { xcd_barrier(); phase_gate(p, opaque_tid() >= 0 ? 1 : 0); }
  xcd_barrier();
  SLOT(4, phase_s5y(p)); __syncthreads(); SLOT(42, phase_xattn(p)); __syncthreads();
  phase_moba(p); if (REP_PHASE == 41) { xcd_barrier(); phase_moba(p, opaque_tid() >= 0 ? 1 : 0); } if (REP_PHASE == 43) { xcd_barrier(); phase_moba(p, opaque_tid() >= 0 ? 2 : 0); }
  xcd_barrier();
  SLOT(5, phase_moba_combine(p)); __syncthreads(); SLOT(51, phase_glu(p));
  xcd_barrier();
  phase_moco(p); if (REP_PHASE == 6) { xcd_barrier(); phase_moco(p, opaque_tid() >= 0 ? 1 : 0); }
  xcd_barrier();
  SLOT(7, phase_outproj(p));
  xcd_barrier();
  phase_route(p); if (REP_PHASE == 8) { xcd_barrier(); phase_route(p, opaque_tid() >= 0 ? 1 : 0); }
  xcd_barrier();
  SLOT(9, phase_moe1(p));
  xcd_barrier();
  SLOT(10, phase_moe2(p));
  xcd_barrier();
  phase_moe_combine(p); if (REP_PHASE == 11) { xcd_barrier(); phase_moe_combine(p, opaque_tid() >= 0 ? 1 : 0); }
}

extern "C" void kernel_launch(void* const* d_in, const int* in_sizes, int n_in, void* d_out, int out_size, void* d_ws,
                              size_t ws_size, hipStream_t stream) {
  (void)in_sizes; (void)out_size;
  static int grid_blocks = 0;
  if (!grid_blocks) {
    int dev = 0, cus = 0, per_cu = 0;
    (void)hipGetDevice(&dev);
    (void)hipDeviceGetAttribute(&cus, hipDeviceAttributeMultiprocessorCount, dev);
    (void)hipFuncSetAttribute((const void*)mega, hipFuncAttributeMaxDynamicSharedMemorySize, LDS_TOTAL);
    (void)hipOccupancyMaxActiveBlocksPerMultiprocessor(&per_cu, (const void*)mega, NTHR, LDS_TOTAL);
    if (per_cu < 1) { fprintf(stderr, "kernel_launch: occupancy query reports %d blocks/CU\n", per_cu); per_cu = 1; }
    grid_blocks = cus;
  }
  if (n_in != 29 || ws_size < WS_END_A) { fprintf(stderr, "kernel_launch: bad inputs (n_in %d) or workspace too small: %zu < %zu\n", n_in, ws_size, (size_t)WS_END_A); return; }
  MP mp{};
  for (int i = 0; i < 29; ++i) mp.in[i] = (const float*)d_in[i];
  mp.out = (float*)d_out;
  mp.ws = (unsigned char*)d_ws;
  mp.ph_lo = 0; mp.ph_hi = PH_COUNT;
  (void)hipMemsetAsync((unsigned char*)d_ws + WS_BAR, 0, 16384, stream);
  void* args[] = {&mp};
  hipError_t e = hipLaunchCooperativeKernel((const void*)mega, dim3(grid_blocks), dim3(NTHR), args, LDS_TOTAL, stream);
  if (e != hipSuccess) fprintf(stderr, "cooperative launch failed: %s (grid %d)\n", hipGetErrorString(e), grid_blocks);
}
```
